# Optimizing an MI355X kernel written in HIP

```python
import math
import jax, jax.numpy as jnp
from jax import lax
import numpy as np

D_MODEL = 1024
BATCH = 32
SEQ = 256
DEPTH = 4
DEC_BATCH = 4
DEC_SEQ = 2048
PAST_LEN = 256

GRID_W = 64
HEAD_DIM = 64
DIFF_HEADS = 4
DIFF_V_DIM = 2 * HEAD_DIM
MLA_HEADS = 8
MLA_Q_RANK = 256
MLA_KV_RANK = 128
MLA_NOPE_DIM = 64
MLA_ROPE_DIM = 32
MLA_QK_DIM = MLA_NOPE_DIM + MLA_ROPE_DIM
MLA_V_DIM = 64
GQA_HEADS = 8
GQA_KV_HEADS = 2
GQA_REP = GQA_HEADS // GQA_KV_HEADS
D_FF = 2816
CONV_WIDTH = 3
ROPE_BASE = 10000.0
NORM_EPS = 1e-6
Q_BLOCK = 128
N_BRANCH = 3

A_WIDTH = DIFF_HEADS * DIFF_V_DIM
B_WIDTH = MLA_HEADS * MLA_V_DIM
C_WIDTH = GQA_HEADS * HEAD_DIM

IN_SIZES = (2 * DIFF_HEADS * HEAD_DIM,
            2 * DIFF_HEADS * HEAD_DIM,
            DIFF_HEADS * DIFF_V_DIM,
            MLA_Q_RANK,
            MLA_KV_RANK + MLA_ROPE_DIM,
            GQA_HEADS * HEAD_DIM,
            GQA_KV_HEADS * HEAD_DIM,
            GQA_KV_HEADS * HEAD_DIM,
            N_BRANCH * D_MODEL)
IN_COLS = sum(IN_SIZES)
IN_SPLITS = tuple(int(s) for s in np.cumsum(IN_SIZES)[:-1])

kernel_name = 'hybrid_diffusion_prefix_step'


def rms_norm(x, g):
    xf = x.astype(jnp.float32)
    y = xf * lax.rsqrt(jnp.mean(xf * xf, axis=-1, keepdims=True) + NORM_EPS)
    return (y * g.astype(jnp.float32)).astype(x.dtype)


def axial_rope_tables(n_tokens, dim):
    rows = n_tokens // GRID_W
    row = jnp.repeat(jnp.arange(rows, dtype=jnp.float32), GRID_W)
    col = jnp.tile(jnp.arange(GRID_W, dtype=jnp.float32), rows)
    quarter = dim // 4
    inv = 1.0 / (ROPE_BASE ** (jnp.arange(quarter, dtype=jnp.float32) / quarter))
    ang = jnp.concatenate([row[:, None] * inv, col[:, None] * inv], axis=-1)
    return jnp.cos(ang), jnp.sin(ang)


def apply_rope(x, cos, sin):
    half = x.shape[-1] // 2
    shape = (x.shape[1],) + (1,) * (x.ndim - 3) + (half,)
    cos = cos.reshape(shape).astype(x.dtype)
    sin = sin.reshape(shape).astype(x.dtype)
    x1, x2 = x[..., :half], x[..., half:]
    return jnp.concatenate([x1 * cos - x2 * sin, x1 * sin + x2 * cos], axis=-1)


def over_query_blocks(fn, q):
    b, t = q.shape[:2]
    nb = t // Q_BLOCK
    blocks = jnp.moveaxis(q.reshape((b, nb, Q_BLOCK) + q.shape[2:]), 1, 0)
    out = jnp.moveaxis(lax.map(fn, blocks), 0, 1)
    return out.reshape((b, t) + out.shape[3:])


def gqa_block(q, k, v):
    scale = q.shape[-1] ** -0.5
    s = jnp.einsum('bqgrd,bsgd->bgrqs', q, k).astype(jnp.float32) * scale
    p = jax.nn.softmax(s, axis=-1).astype(v.dtype)
    return jnp.einsum('bgrqs,bsge->bqgre', p, v)


def diff_block(q, k, v, lam):
    scale = q.shape[-1] ** -0.5
    s = jnp.einsum('bqmhd,bsmhd->bmhqs', q, k).astype(jnp.float32) * scale
    p = jax.nn.softmax(s, axis=-1)
    w = (p[:, 0] - lam * p[:, 1]).astype(v.dtype)
    return jnp.einsum('bhqs,bshe->bqhe', w, v)


def mla_expand(ckv, kpe, p):
    b, s = ckv.shape[:2]
    kv = (rms_norm(ckv, p['mla_kv_norm']) @ p['w_mla_kv_up']).reshape(b, s, MLA_HEADS, MLA_NOPE_DIM + MLA_V_DIM)
    k_nope, v = kv[..., :MLA_NOPE_DIM], kv[..., MLA_NOPE_DIM:]
    k_pe = jnp.broadcast_to(kpe[:, :, None, :], (b, s, MLA_HEADS, MLA_ROPE_DIM))
    k = rms_norm(jnp.concatenate([k_nope, k_pe], axis=-1), p['mla_qk_norm'][1])
    return k, v


def rope_tail(x, cos, sin):
    return jnp.concatenate([x[..., :MLA_NOPE_DIM], apply_rope(x[..., MLA_NOPE_DIM:], cos, sin)], axis=-1)


def token_mixers(h, p, lam_init, rope, ctx):
    b, t, _ = h.shape
    aq, ak, av, bq_d, bkv_d, cq, ck, cv, gates = jnp.split(h @ p['w_in'], IN_SPLITS, axis=-1)
    aq = rms_norm(aq.reshape(b, t, 2, DIFF_HEADS, HEAD_DIM), p['diff_qk_norm'][0])
    ak = rms_norm(ak.reshape(b, t, 2, DIFF_HEADS, HEAD_DIM), p['diff_qk_norm'][1])
    av = av.reshape(b, t, DIFF_HEADS, DIFF_V_DIM)
    bq = (rms_norm(bq_d, p['mla_q_norm']) @ p['w_mla_q_up']).reshape(b, t, MLA_HEADS, MLA_QK_DIM)
    bq = rms_norm(bq, p['mla_qk_norm'][0])
    ckv, kpe = bkv_d[..., :MLA_KV_RANK], bkv_d[..., MLA_KV_RANK:]
    bk, bv = mla_expand(ckv, kpe, p)
    cq = rms_norm(cq.reshape(b, t, GQA_HEADS, HEAD_DIM), p['gqa_qk_norm'][0])
    ck = rms_norm(ck.reshape(b, t, GQA_KV_HEADS, HEAD_DIM), p['gqa_qk_norm'][1])
    cv = cv.reshape(b, t, GQA_KV_HEADS, HEAD_DIM)
    own_ctx = (ak, av, ckv, kpe, ck, cv)

    if rope is not None:
        (cos_h, sin_h), (cos_r, sin_r) = rope
        aq, ak = apply_rope(aq, cos_h, sin_h), apply_rope(ak, cos_h, sin_h)
        bq, bk = rope_tail(bq, cos_r, sin_r), rope_tail(bk, cos_r, sin_r)
        cq, ck = apply_rope(cq, cos_h, sin_h), apply_rope(ck, cos_h, sin_h)
        c_ak, c_av, c_ckv, c_kpe, c_ck, c_cv = ctx
        c_bk, c_bv = mla_expand(c_ckv, c_kpe, p)
        ak = jnp.concatenate([c_ak, ak], axis=1)
        av = jnp.concatenate([c_av, av], axis=1)
        bk = jnp.concatenate([c_bk, bk], axis=1)
        bv = jnp.concatenate([c_bv, bv], axis=1)
        ck = jnp.concatenate([c_ck, ck], axis=1)
        cv = jnp.concatenate([c_cv, cv], axis=1)

    lam_vecs = p['diff_lambda'].astype(jnp.float32)
    lam = (jnp.exp(jnp.sum(lam_vecs[0] * lam_vecs[1])) - jnp.exp(jnp.sum(lam_vecs[2] * lam_vecs[3])) + lam_init)
    oa = over_query_blocks(lambda qb: diff_block(qb, ak, av, lam), aq)
    oa = (rms_norm(oa, p['diff_out_norm']) * (1.0 - lam_init)).reshape(b, t, A_WIDTH)
    ob = over_query_blocks(lambda qb: gqa_block(qb, bk, bv), bq[:, :, :, None, :]).reshape(b, t, B_WIDTH)
    oc = over_query_blocks(lambda qb: gqa_block(qb, ck, cv),
                           cq.reshape(b, t, GQA_KV_HEADS, GQA_REP, HEAD_DIM)).reshape(b, t, C_WIDTH)

    g = jax.nn.sigmoid(gates.reshape(b, t, N_BRANCH, D_MODEL))
    merged = (g[:, :, 0] * (oa @ p['w_branch_a']) + g[:, :, 1] * (ob @ p['w_branch_b'])
              + g[:, :, 2] * (oc @ p['w_branch_c']))
    return merged @ p['w_o'], own_ctx


def conv_ffn(h, p):
    u = h @ p['w_up']
    t = u.shape[1]
    pad = CONV_WIDTH // 2
    up = jnp.pad(u, ((0, 0), (pad, pad), (0, 0)))
    w = p['conv_w']
    u = up[:, 0:t] * w[0] + up[:, 1:t + 1] * w[1] + up[:, 2:t + 2] * w[2] + p['conv_b']
    a, gt = u[..., :D_FF], u[..., D_FF:]
    return (a * jax.nn.silu(gt)) @ p['w_down']


def trunk_layer(x, mod, p, lam_init, rope, ctx):
    shift_m, scale_m, gate_m, shift_f, scale_f, gate_f = jnp.split(mod, 6, axis=-1)
    h = rms_norm(x, p['norm_mix']) * (1.0 + scale_m) + shift_m
    mix, own_ctx = token_mixers(h, p, lam_init, rope, ctx)
    x = x + gate_m * mix
    h = rms_norm(x, p['norm_ffn']) * (1.0 + scale_f) + shift_f
    x = x + gate_f * conv_ffn(h, p)
    return x, own_ctx


def setup_inputs(seed: int = 0) -> dict:
    key = jax.random.key(seed)
    ks = iter(jax.random.split(key, 40))

    def nrm(shape, scale=1.0):
        return jax.random.normal(next(ks), shape, jnp.float32) * scale

    def gain(shape):
        return 1.0 + nrm(shape, 0.05)

    L, D = DEPTH, D_MODEL
    return {
        'x_prompt': nrm((BATCH, SEQ, D)),
        'x_sample': nrm((DEC_BATCH, DEC_SEQ, D)),
        'c': nrm((DEC_BATCH, D)),
        'cache_diff_k': nrm((DEC_BATCH, L, PAST_LEN, 2, DIFF_HEADS, HEAD_DIM)),
        'cache_diff_v': nrm((DEC_BATCH, L, PAST_LEN, DIFF_HEADS, DIFF_V_DIM)),
        'cache_mla_ckv': nrm((DEC_BATCH, L, PAST_LEN, MLA_KV_RANK)),
        'cache_mla_kpe': nrm((DEC_BATCH, L, PAST_LEN, MLA_ROPE_DIM)),
        'cache_gqa_k': nrm((DEC_BATCH, L, PAST_LEN, GQA_KV_HEADS, HEAD_DIM)),
        'cache_gqa_v': nrm((DEC_BATCH, L, PAST_LEN, GQA_KV_HEADS, HEAD_DIM)),
        'c_ctx': nrm((D,)),
        'w_ada': nrm((L, D, 6 * D), 0.5 * D ** -0.5),
        'b_ada': nrm((L, 6 * D), 0.02),
        'norm_mix': gain((L, D)),
        'w_in': nrm((L, D, IN_COLS), D ** -0.5),
        'diff_qk_norm': gain((L, 2, HEAD_DIM)),
        'diff_lambda': nrm((L, 4, HEAD_DIM), 0.1),
        'diff_out_norm': gain((L, DIFF_V_DIM)),
        'mla_q_norm': gain((L, MLA_Q_RANK)),
        'w_mla_q_up': nrm((L, MLA_Q_RANK, MLA_HEADS * MLA_QK_DIM), MLA_Q_RANK ** -0.5),
        'mla_kv_norm': gain((L, MLA_KV_RANK)),
        'w_mla_kv_up': nrm((L, MLA_KV_RANK, MLA_HEADS * (MLA_NOPE_DIM + MLA_V_DIM)), MLA_KV_RANK ** -0.5),
        'mla_qk_norm': gain((L, 2, MLA_QK_DIM)),
        'gqa_qk_norm': gain((L, 2, HEAD_DIM)),
        'w_branch_a': nrm((L, A_WIDTH, D), A_WIDTH ** -0.5),
        'w_branch_b': nrm((L, B_WIDTH, D), B_WIDTH ** -0.5),
        'w_branch_c': nrm((L, C_WIDTH, D), C_WIDTH ** -0.5),
        'w_o': nrm((L, D, D), D ** -0.5),
        'norm_ffn': gain((L, D)),
        'w_up': nrm((L, D, 2 * D_FF), D ** -0.5),
        'conv_w': nrm((L, CONV_WIDTH, 2 * D_FF), CONV_WIDTH ** -0.5),
        'conv_b': nrm((L, 2 * D_FF), 0.02),
        'w_down': nrm((L, D_FF, D), D_FF ** -0.5),
    }


def reference(x_prompt, x_sample, c, cache_diff_k, cache_diff_v, cache_mla_ckv, cache_mla_kpe,
              cache_gqa_k, cache_gqa_v, c_ctx, w_ada, b_ada, norm_mix, w_in, diff_qk_norm,
              diff_lambda, diff_out_norm, mla_q_norm, w_mla_q_up, mla_kv_norm, w_mla_kv_up,
              mla_qk_norm, gqa_qk_norm, w_branch_a, w_branch_b, w_branch_c, w_o, norm_ffn,
              w_up, conv_w, conv_b, w_down):
    t_lat = x_sample.shape[1]
    rope = (axial_rope_tables(t_lat, HEAD_DIM), axial_rope_tables(t_lat, MLA_ROPE_DIM))
    y_p, y_s = x_prompt, x_sample
    states = []
    for l in range(DEPTH):
        p = {
            'norm_mix': norm_mix[l], 'w_in': w_in[l], 'diff_qk_norm': diff_qk_norm[l],
            'diff_lambda': diff_lambda[l], 'diff_out_norm': diff_out_norm[l],
            'mla_q_norm': mla_q_norm[l], 'w_mla_q_up': w_mla_q_up[l],
            'mla_kv_norm': mla_kv_norm[l], 'w_mla_kv_up': w_mla_kv_up[l],
            'mla_qk_norm': mla_qk_norm[l], 'gqa_qk_norm': gqa_qk_norm[l],
            'w_branch_a': w_branch_a[l], 'w_branch_b': w_branch_b[l], 'w_branch_c': w_branch_c[l],
            'w_o': w_o[l], 'norm_ffn': norm_ffn[l], 'w_up': w_up[l], 'conv_w': conv_w[l],
            'conv_b': conv_b[l], 'w_down': w_down[l],
        }
        lam_init = 0.8 - 0.6 * math.exp(-0.3 * l)
        mod_ctx = (jax.nn.silu(c_ctx) @ w_ada[l] + b_ada[l])[None, None, :]
        mod_lat = (jax.nn.silu(c) @ w_ada[l] + b_ada[l])[:, None, :]
        y_p, own_ctx = trunk_layer(y_p, mod_ctx, p, lam_init, None, None)
        states.append(own_ctx)
        ctx = (cache_diff_k[:, l], cache_diff_v[:, l], cache_mla_ckv[:, l], cache_mla_kpe[:, l],
               cache_gqa_k[:, l], cache_gqa_v[:, l])
        y_s, _ = trunk_layer(y_s, mod_lat, p, lam_init, rope, ctx)
    new_diff_k = jnp.stack([s[0] for s in states], axis=1)
    new_diff_v = jnp.stack([s[1] for s in states], axis=1)
    new_mla_ckv = jnp.stack([s[2] for s in states], axis=1)
    new_mla_kpe = jnp.stack([s[3] for s in states], axis=1)
    new_gqa_k = jnp.stack([s[4] for s in states], axis=1)
    new_gqa_v = jnp.stack([s[5] for s in states], axis=1)
    return (y_p, y_s, new_diff_k, new_diff_v, new_mla_ckv, new_mla_kpe, new_gqa_k, new_gqa_v)
```

```cpp
#include <hip/hip_runtime.h>
#include <hip/hip_bf16.h>
#include <hip/hip_cooperative_groups.h>
#include <cstdio>
namespace cg = cooperative_groups;

typedef unsigned short u16;
using bf16x8 = __attribute__((ext_vector_type(8))) short;
using s16x4  = __attribute__((ext_vector_type(4))) short;
using f32x4  = __attribute__((ext_vector_type(4))) float;
using f32x16 = __attribute__((ext_vector_type(16))) float;
#define DI __device__ __forceinline__

constexpr int D = 1024, NTOK = 16384, NCTX = 8192, DEPTH = 4;
constexpr int SEQ = 256, DEC_SEQ = 2048, PAST = 256, SLAT = PAST + DEC_SEQ;
constexpr int KVROWS = NCTX + 4 * SLAT;
constexpr int IN_COLS = 5792, PLD = 5888;
constexpr int C_AQ = 0, C_AK = 512, C_AV = 1024, C_BQD = 1536, C_CQ = 1792, C_CK = 2304, C_CV = 2432, C_CKV = 2560, C_KPE = 2688, C_GATE = 2816;
constexpr int C_MLAQ = 512;
constexpr int DFF = 2816, UP = 5632;
constexpr float EPS = 1e-6f;
constexpr float LOG2E = 1.4426950408889634f;

constexpr int XCD_BAR_WORDS_C = 3456;
constexpr size_t al256(size_t x) { return (x + 255) & ~(size_t)255; }
constexpr size_t WS_WIN  = 0;
constexpr size_t WS_WQU  = WS_WIN + al256((size_t)PLD * 1024 * 2);
constexpr size_t WS_WKV  = WS_WQU + al256((size_t)1024 * 256 * 2);
constexpr size_t WS_WB   = WS_WKV + al256((size_t)1024 * 256 * 2);
constexpr size_t WS_WO   = WS_WB + al256((size_t)3 * 1024 * 512 * 2);
constexpr size_t WS_WUP  = WS_WO + al256((size_t)1024 * 1024 * 2);
constexpr size_t WS_WD   = WS_WUP + al256((size_t)UP * 1024 * 2);
constexpr size_t WS_H    = WS_WD + al256((size_t)1024 * DFF * 2);
constexpr size_t WS_PROJ = WS_H + al256((size_t)NTOK * 1024 * 2);
constexpr size_t WS_KV   = WS_PROJ + al256((size_t)NTOK * PLD * 2);
constexpr size_t WS_DK   = WS_KV;
constexpr size_t WS_DV   = WS_DK + al256((size_t)KVROWS * 512 * 2);
constexpr size_t WS_MK   = WS_DV + al256((size_t)KVROWS * 512 * 2);
constexpr size_t WS_MV   = WS_MK + al256((size_t)KVROWS * 768 * 2);
constexpr size_t WS_GK   = WS_MV + al256((size_t)KVROWS * 512 * 2);
constexpr size_t WS_GV   = WS_GK + al256((size_t)KVROWS * 128 * 2);
constexpr size_t WS_CKVN = WS_GV + al256((size_t)KVROWS * 128 * 2);
constexpr size_t WS_KPE  = WS_CKVN + al256((size_t)KVROWS * 256 * 2);
constexpr size_t WS_OB   = WS_KPE + al256((size_t)KVROWS * 32 * 4);
constexpr size_t WS_MOD  = WS_OB + al256((size_t)NTOK * 1536 * 2);
constexpr size_t WS_MODP = WS_MOD + al256((size_t)4 * 5 * 6144 * 4);
constexpr size_t WS_ROPE = WS_MODP + al256((size_t)16 * 4 * 5 * 6144 * 4);
constexpr size_t WS_CTR  = WS_ROPE + al256((size_t)2048 * 96 * 4);
constexpr size_t WS_BAR  = WS_CTR + 256;
constexpr size_t WS_O0   = WS_BAR + al256((size_t)XCD_BAR_WORDS_C * 4);
constexpr size_t WS_HALO = WS_O0 + al256((size_t)NTOK * 512 * 4);
constexpr size_t WS_QDSS = WS_HALO + al256((size_t)32 * 22 * 4 * 256 * 2);
constexpr size_t WS_END  = WS_QDSS + al256((size_t)NTOK * 2 * 4);
constexpr size_t WS_M32  = WS_KV;
constexpr size_t WS_ACT  = WS_KV;
static_assert(WS_OB + (size_t)NTOK * 1536 * 2 - WS_KV >= (size_t)NTOK * DFF * 2, "act alias");
static_assert(WS_OB - WS_KV >= (size_t)NTOK * 1024 * 4, "m32 alias");

constexpr int LDS_BYTES = 136192;

struct Params {
  const float* in[32];
  float* out;
  char* ws;
};

constexpr size_t O_X = 0, O_NDK = 16777216, O_NDV = 33554432, O_NCKV = 50331648, O_NKPE = 54525952, O_NGK = 55574528, O_NGV = 59768832;

DI u16 f2bf(float x) { unsigned u = __float_as_uint(x); u += 0x7fffu + ((u >> 16) & 1u); return (u16)(u >> 16); }
DI float bf2f(u16 v) { return __uint_as_float(((unsigned)v) << 16); }
typedef __bf16 bf16x2_t __attribute__((ext_vector_type(2)));
typedef float f32x2_t __attribute__((ext_vector_type(2)));
DI unsigned pk2(float a, float b) { f32x2_t f; f[0] = a; f[1] = b; return __builtin_bit_cast(unsigned, __builtin_convertvector(f, bf16x2_t)); }
DI void unpack8(uint4 r, float* x) {
  x[0] = __uint_as_float(r.x << 16); x[1] = __uint_as_float(r.x & 0xffff0000u);
  x[2] = __uint_as_float(r.y << 16); x[3] = __uint_as_float(r.y & 0xffff0000u);
  x[4] = __uint_as_float(r.z << 16); x[5] = __uint_as_float(r.z & 0xffff0000u);
  x[6] = __uint_as_float(r.w << 16); x[7] = __uint_as_float(r.w & 0xffff0000u);
}
DI uint4 pack8(const float* x) { uint4 r; r.x = pk2(x[0], x[1]); r.y = pk2(x[2], x[3]); r.z = pk2(x[4], x[5]); r.w = pk2(x[6], x[7]); return r; }
DI void ld8f(const float* p, float* x) { float4 a = *(const float4*)p, b = *(const float4*)(p + 4); x[0]=a.x;x[1]=a.y;x[2]=a.z;x[3]=a.w;x[4]=b.x;x[5]=b.y;x[6]=b.z;x[7]=b.w; }
DI void st8f(float* p, const float* x) { *(float4*)p = make_float4(x[0],x[1],x[2],x[3]); *(float4*)(p + 4) = make_float4(x[4],x[5],x[6],x[7]); }
template <int M> DI float shx(float v) {
  if constexpr (M < 32) return __int_as_float(__builtin_amdgcn_ds_swizzle(__float_as_int(v), (M << 10) | 0x1f));
  else {
    unsigned z = 0u; asm volatile("" : "+v"(z));
    const unsigned lane = __builtin_amdgcn_mbcnt_hi(~0u, __builtin_amdgcn_mbcnt_lo(~0u, z));
    return __int_as_float(__builtin_amdgcn_ds_bpermute((int)((lane ^ 32u) << 2), __float_as_int(v)));
  }
}
DI float wave_sum(float v) { v += shx<32>(v); v += shx<16>(v); v += shx<8>(v); v += shx<4>(v); v += shx<2>(v); v += shx<1>(v); return v; }
DI float siluf(float x) { return x * __builtin_amdgcn_rcpf(1.f + __expf(-x)); }
DI float sigmoidf(float x) { return __builtin_amdgcn_rcpf(1.f + __expf(-x)); }
__shared__ unsigned g_wslot[64];
DI unsigned hw_slot() { return (unsigned)__builtin_amdgcn_s_getreg((6 << 11) | 4) & 63u; }
DI void otid_init() {
  const unsigned t = threadIdx.x;
  if ((t & 63u) == 0u) g_wslot[hw_slot()] = t >> 6;
  __syncthreads();
}
DI int otid() {
  const unsigned w = (unsigned)__builtin_amdgcn_readfirstlane((int)((volatile __attribute__((address_space(3))) unsigned*)g_wslot)[hw_slot()]);
  unsigned z = 0u; asm volatile("" : "+v"(z));
  int t = (int)(w * 64u + __builtin_amdgcn_mbcnt_hi(~0u, __builtin_amdgcn_mbcnt_lo(~0u, z)));
  asm volatile("" : "+v"(t));
  return t;
}
DI int obid() { int b = blockIdx.x; asm volatile("" : "+s"(b)); return b; }
DI int ogrid() { int g = gridDim.x; asm volatile("" : "+s"(g)); return g; }
DI char* ows(char* w) { size_t z = 0; asm volatile("" : "+s"(z)); return w + z; }
DI float uni(float x) { return __int_as_float(__builtin_amdgcn_readfirstlane(__float_as_int(x))); }
DI int tok_group(int t) { return t < NCTX ? 0 : 1 + ((t - NCTX) >> 11); }


#define XB_TMO      128
#define XB_XCNT(j)  (256  + 64 * (j))
#define XB_XSUB(j)  (1280 + 64 * (j))
#define XB_XGEN(j)  (2304 + 64 * (j))
#define XB_TOP      3328
#define XB_TOPGEN   3392
#define XCD_BAR_WORDS 3456
#define XB_SPIN_CAP (1u << 18)
#define LAS __attribute__((address_space(3)))
DI unsigned xb_ld(unsigned* p)              { return __hip_atomic_load(p, __ATOMIC_RELAXED, __HIP_MEMORY_SCOPE_AGENT); }
DI unsigned xb_add(unsigned* p, unsigned v) { return __hip_atomic_fetch_add(p, v, __ATOMIC_RELAXED, __HIP_MEMORY_SCOPE_AGENT); }
DI unsigned xb_xcc_id() { return (unsigned)__builtin_amdgcn_s_getreg((3 << 11) | 20) & 0xFu; }
#define XB_SPIN(cond, bar) do { unsigned _sp = 0; while (cond) { __builtin_amdgcn_s_sleep(1); \
    if ((++_sp & 255u) == 0u) { if (xb_ld(&(bar)[XB_TMO])) break; if (_sp > XB_SPIN_CAP) { atomicAdd(&(bar)[XB_TMO], 1u); break; } } } } while (0)
struct XcdBarrier { unsigned* bar; unsigned x; volatile LAS unsigned* st; };
DI XcdBarrier xcd_barrier_post(unsigned* bar, volatile LAS unsigned* st) {
  XcdBarrier b; b.bar = bar; b.x = xb_xcc_id(); b.st = st;
  if (otid() == 0) st[2] = xb_add(&bar[XB_XCNT(b.x)], 1u);
  return b;
}
DI void xcd_barrier_complete(unsigned* bar, unsigned x, unsigned& nloc, unsigned& nx) {
  const unsigned G = gridDim.x;
  unsigned sum, cnt, mine, sp = 0u;
  for (;;) {
    sum = 0u; cnt = 0u; mine = 0u;
#pragma unroll
    for (unsigned j = 0; j < 16; ++j) { const unsigned c = xb_ld(&bar[XB_XCNT(j)]); sum += c; cnt += (c > 0u) ? 1u : 0u; mine = (j == x) ? c : mine; }
    if (sum == G) break;
    __builtin_amdgcn_s_sleep(1);
    if ((++sp & 255u) == 0u) { if (xb_ld(&bar[XB_TMO])) break; if (sp > XB_SPIN_CAP) { atomicAdd(&bar[XB_TMO], 1u); break; } }
  }
  nloc = mine > 0u ? mine : 1u; nx = cnt > 0u ? cnt : 1u;
}
DI void xcd_barrier(const XcdBarrier& b) {
  asm volatile("s_waitcnt vmcnt(0)" ::: "memory");
  __syncthreads();
  if (otid() == 0) {
    unsigned* bar = b.bar; unsigned bx = b.x;
    asm volatile("" : "+s"(bar), "+s"(bx));
    __builtin_amdgcn_s_waitcnt(0);
    unsigned nloc = b.st[0], nx = b.st[1];
    const unsigned old = xb_add(&bar[XB_XSUB(bx)], 1u);
    const unsigned gen = old / nloc;
    if (old + 1u == (gen + 1u) * nloc) {
      __builtin_amdgcn_fence(__ATOMIC_RELEASE, "agent");
      asm volatile("s_waitcnt vmcnt(0)" ::: "memory");
      const unsigned og = xb_add(&bar[XB_TOP], 1u);
      const unsigned tg = og / nx;
      if (og + 1u == (tg + 1u) * nx) xb_add(&bar[XB_TOPGEN], 1u);
      else XB_SPIN(xb_ld(&bar[XB_TOPGEN]) == tg, bar);
      __builtin_amdgcn_fence(__ATOMIC_ACQUIRE, "agent");
      xb_add(&bar[XB_XGEN(bx)], 1u);
      asm volatile("s_waitcnt vmcnt(0)" ::: "memory");
    } else {
      XB_SPIN(xb_ld(&bar[XB_XGEN(bx)]) == gen, bar);
      __builtin_amdgcn_fence(__ATOMIC_ACQUIRE, "agent");
      asm volatile("s_waitcnt vmcnt(0)" ::: "memory");
    }
  }
  __syncthreads();
}

constexpr int BM = 256, BK = 64, HALF = 128, HT = HALF * BK;
DI int lds_byte(int r, int c) {
  int st = (r >> 4) * 2 + (c >> 5), rr = r & 15, cc = c & 31, ob = rr * 64 + cc * 2;
  return st * 1024 + (ob ^ (((ob >> 9) & 1) << 5));
}
DI void stage_rc(int b, int& R, int& C) {
  int st = b / 1024, sb = b % 1024, swz = sb ^ (((sb >> 9) & 1) << 5);
  R = (st >> 1) * 16 + swz / 64; C = (st & 1) * 32 + (swz % 64) / 2;
}
constexpr int EPLD = 132;

template <bool ZERO>
DI void gemm_kloop(const u16* __restrict__ A, int lda, const u16* __restrict__ Bt, int ldb, int K, int brow, int bcol, char* smem, f32x4 (&acc)[2][2][4][2], int tid) {
  u16* shm = (u16*)smem;
  brow = __builtin_amdgcn_readfirstlane(brow); bcol = __builtin_amdgcn_readfirstlane(bcol);
#define SA(b,h) (shm+((b)*2+(h))*HT)
#define SB(b,h) (shm+(4+(b)*2+(h))*HT)
#define STAGE_(P,BASE,LD,br,kt,O0,O1) do{ const char* _gb=(const char*)((BASE)+((long)(br)*(LD)+(long)(kt)*BK)); asm volatile("" : "+s"(_gb)); \
    unsigned _o0=(O0), _o1=(O1); asm volatile("" : "+v"(_o0), "+v"(_o1)); \
    __builtin_amdgcn_global_load_lds((const unsigned*)(_gb+(size_t)_o0), (unsigned*)((char*)(P)+wv1024),16,0,0); \
    __builtin_amdgcn_global_load_lds((const unsigned*)(_gb+(size_t)_o1), (unsigned*)((char*)(P)+wv1024+8192),16,0,0); \
    }while(0)
#define STAGE(P,BASE,LD,br,kt) STAGE_##BASE(P,BASE,LD,br,kt)
#define STAGE_A(P,BASE,LD,br,kt) STAGE_(P,BASE,LD,br,kt,aoff0,aoff1)
#define STAGE_Bt(P,BASE,LD,br,kt) STAGE_(P,BASE,LD,br,kt,boff0,boff1)
#define LDA(dst,b,h) for(int m=0;m<4;++m)for(int k=0;k<2;++k) \
    dst[m][k]=*reinterpret_cast<const bf16x8*>((char*)SA(b,h)+lds_byte(wr*64+m*16+fr,k*32+fq*8))
#define LDB(dst,b,h) for(int n=0;n<2;++n)for(int k=0;k<2;++k) \
    dst[n][k]=*reinterpret_cast<const bf16x8*>((char*)SB(b,h)+lds_byte(wc*32+n*16+fr,k*32+fq*8))
#define MMA(ai,bj,At,Bx) do{__builtin_amdgcn_s_setprio(1); \
    for(int m=0;m<4;++m)for(int n=0;n<2;++n)for(int k=0;k<2;++k) \
      acc[ai][bj][m][n]=__builtin_amdgcn_mfma_f32_16x16x32_bf16(At[m][k],Bx[n][k],acc[ai][bj][m][n],0,0,0); \
    __builtin_amdgcn_s_setprio(0);}while(0)
#define WAIT_V(n) asm volatile("s_waitcnt vmcnt(" #n ")":::"memory")
#define WAIT_L(n) asm volatile("s_waitcnt lgkmcnt(" #n ")":::"memory")
#define BAR __builtin_amdgcn_s_barrier()
#define SCHED __builtin_amdgcn_sched_barrier(0)
  const int wid = tid >> 6, lane = tid & 63, wr = wid >> 2, wc = wid & 3, fr = lane & 15, fq = lane >> 4;
  if (ZERO) {
#pragma unroll
    for (int a = 0; a < 2; ++a)
#pragma unroll
      for (int b = 0; b < 2; ++b)
#pragma unroll
        for (int m = 0; m < 4; ++m)
#pragma unroll
          for (int n = 0; n < 2; ++n) acc[a][b][m][n] = f32x4{0.f, 0.f, 0.f, 0.f};
  }
  bf16x8 At[4][2], B0[2][2], B1[2][2];
  const int nt = K / BK;
  const int wv1024 = __builtin_amdgcn_readfirstlane(tid >> 6) * 1024;
  unsigned aoff0, aoff1, boff0, boff1;
  { int _r, _c; stage_rc(tid * 16, _r, _c); aoff0 = (unsigned)(_r * lda + _c) * 2u; boff0 = (unsigned)(_r * ldb + _c) * 2u;
    stage_rc(tid * 16 + 8192, _r, _c); aoff1 = (unsigned)(_r * lda + _c) * 2u; boff1 = (unsigned)(_r * ldb + _c) * 2u; }
  asm volatile("s_waitcnt vmcnt(0) lgkmcnt(0)" ::: "memory");
  __syncthreads();
  STAGE(SB(0,0),Bt,ldb,bcol,0); STAGE(SA(0,0),A,lda,brow,0);
  STAGE(SB(0,1),Bt,ldb,bcol+HALF,0); STAGE(SA(0,1),A,lda,brow+HALF,0);
  if (wr == 1) BAR;
  WAIT_V(4); BAR;
  STAGE(SB(1,0),Bt,ldb,bcol,1); STAGE(SA(1,0),A,lda,brow,1); STAGE(SB(1,1),Bt,ldb,bcol+HALF,1);
  WAIT_V(6); BAR;
  for (int t = 0; t < nt - 2; t += 2) {
    LDB(B0,0,0); SCHED; LDA(At,0,0); STAGE(SA(1,1),A,lda,brow+HALF,t+1);
    WAIT_L(8); BAR; WAIT_L(0); MMA(0,0,At,B0); BAR; SCHED;
    LDB(B1,0,1); STAGE(SB(0,0),Bt,ldb,bcol,t+2);
    BAR; WAIT_L(0); MMA(0,1,At,B1); BAR;
    LDA(At,0,1); STAGE(SA(0,0),A,lda,brow,t+2);
    BAR; WAIT_L(0); MMA(1,0,At,B0); BAR; SCHED;
    STAGE(SB(0,1),Bt,ldb,bcol+HALF,t+2);
    WAIT_V(6); BAR; MMA(1,1,At,B1); BAR;
    LDB(B0,1,0); SCHED; LDA(At,1,0); STAGE(SA(0,1),A,lda,brow+HALF,t+2);
    WAIT_L(8); BAR; WAIT_L(0); MMA(0,0,At,B0); BAR; SCHED;
    LDB(B1,1,1); STAGE(SB(1,0),Bt,ldb,bcol,t+3);
    BAR; WAIT_L(0); MMA(0,1,At,B1); BAR;
    LDA(At,1,1); STAGE(SA(1,0),A,lda,brow,t+3);
    BAR; WAIT_L(0); MMA(1,0,At,B0); BAR; SCHED;
    STAGE(SB(1,1),Bt,ldb,bcol+HALF,t+3);
    WAIT_V(6); BAR; MMA(1,1,At,B1); BAR;
  }
  { LDB(B0,0,0); LDA(At,0,0); STAGE(SA(1,1),A,lda,brow+HALF,nt-1);
    BAR; WAIT_L(0); MMA(0,0,At,B0); BAR;
    LDB(B1,0,1); BAR; WAIT_L(0); MMA(0,1,At,B1); BAR;
    LDA(At,0,1); WAIT_V(4); BAR; WAIT_L(0); MMA(1,0,At,B0); MMA(1,1,At,B1); BAR; }
  { LDB(B0,1,0); LDA(At,1,0); WAIT_V(2); BAR; WAIT_L(0); MMA(0,0,At,B0); BAR;
    LDB(B1,1,1); WAIT_V(0); BAR; WAIT_L(0); MMA(0,1,At,B1); BAR;
    LDA(At,1,1); BAR; WAIT_L(0); MMA(1,0,At,B0); MMA(1,1,At,B1); BAR; }
  if (wr == 0) BAR;
  __syncthreads();
#undef SA
#undef SB
#undef STAGE
#undef STAGE_
#undef STAGE_A
#undef STAGE_Bt
#undef LDA
#undef LDB
#undef MMA
}

template <class Epi>
DI void gemm_tile(const u16* __restrict__ A, int lda, const u16* __restrict__ Bt, int ldb, int K, int brow, int bcol, char* smem, Epi& epi) {
  f32x4 acc[2][2][4][2];
  gemm_kloop<true>(A, lda, Bt, ldb, K, brow, bcol, smem, acc, otid());
  const int tid = otid();
  const int wid = tid >> 6, lane = tid & 63, wr = wid >> 2, wc = wid & 3, fr = lane & 15, fq = lane >> 4;
  if constexpr (Epi::WHOLE) { epi.whole(acc, brow, bcol, smem, tid); } else {
  float* tile = (float*)smem;
  const int er = tid >> 2, ecs = tid & 3;
#define EPI_QUAD(ai, bj) do { \
    if constexpr (Epi::PRE) epi.pre(brow + (ai) * HALF + er, bcol + (bj) * HALF + ecs * 32); \
    _Pragma("unroll") for (int m = 0; m < 4; ++m) \
    _Pragma("unroll") for (int n = 0; n < 2; ++n) \
    _Pragma("unroll") for (int j = 0; j < 4; ++j) \
      tile[(wr * 64 + m * 16 + fq * 4 + j) * EPLD + wc * 32 + n * 16 + fr] = acc[ai][bj][m][n][j]; \
    __syncthreads(); \
    epi(brow + (ai) * HALF + er, bcol + (bj) * HALF + ecs * 32, tile + er * EPLD + ecs * 32); \
    __syncthreads(); } while (0)
  EPI_QUAD(0, 0); EPI_QUAD(0, 1); EPI_QUAD(1, 0); EPI_QUAD(1, 1);
#undef EPI_QUAD
  }
}

struct EpiProj {
  static constexpr bool WHOLE = false; static constexpr bool PRE = false;
  u16* proj;
  DI void operator()(int row, int col, const float* v) const {
    u16* dst = proj + (size_t)row * PLD + col;
    const bool gate = col >= C_GATE;
#pragma unroll
    for (int c = 0; c < 4; ++c) {
      float x[8];
#pragma unroll
      for (int j = 0; j < 8; ++j) { float t = v[c * 8 + j]; x[j] = gate ? sigmoidf(t) : t; }
      *(uint4*)(dst + c * 8) = pack8(x);
    }
  }
};
struct EpiStore {
  static constexpr bool WHOLE = false; static constexpr bool PRE = false;
  u16* dstp; int ld;
  DI void operator()(int row, int col, const float* v) const {
    u16* dst = dstp + (size_t)row * ld + col;
#pragma unroll
    for (int c = 0; c < 4; ++c) { float x[8];
#pragma unroll
      for (int j = 0; j < 8; ++j) x[j] = v[c * 8 + j];
      *(uint4*)(dst + c * 8) = pack8(x); }
  }
};
struct EpiMerge {
  static constexpr bool WHOLE = false; static constexpr bool PRE = false;
  const u16* proj; float* m32; u16* hb; int pass;
  DI void operator()(int row, int col, const float* v) const {
    const u16* g = proj + (size_t)row * PLD + C_GATE + pass * 1024 + col;
    float* m = m32 + (size_t)row * 1024 + col;
#pragma unroll
    for (int c = 0; c < 4; ++c) {
      float gv[8], x[8];
      unpack8(*(const uint4*)(g + c * 8), gv);
      if (pass > 0) ld8f(m + c * 8, x); else {
#pragma unroll
        for (int j = 0; j < 8; ++j) x[j] = 0.f; }
#pragma unroll
      for (int j = 0; j < 8; ++j) x[j] += gv[j] * v[c * 8 + j];
      if (pass == 2) *(uint4*)(hb + (size_t)row * 1024 + col + c * 8) = pack8(x);
      else st8f(m + c * 8, x);
    }
  }
};
struct EpiResid {
  static constexpr bool WHOLE = false; static constexpr bool EXCH = false; static constexpr bool PRE = true;
  float* x; const float* mod; int goff; const float* src0; const float* src1;
  float4 px[8], pg[8];
  DI void pre(int row, int col) {
    const float* g = mod + tok_group(row) * 6144 + goff + col;
    const float* sp = (row < NCTX ? src0 + (size_t)row * 1024 : src1 + (size_t)(row - NCTX) * 1024) + col;
#pragma unroll
    for (int c = 0; c < 8; ++c) { px[c] = *(const float4*)(sp + c * 4); pg[c] = *(const float4*)(g + c * 4); }
  }
  DI void operator()(int row, int col, const float* v) {
    float* xp = x + (size_t)row * 1024 + col;
#pragma unroll
    for (int c = 0; c < 8; ++c) {
      float4 xv = px[c]; const float4 gv = pg[c];
      xv.x += gv.x * v[c * 4 + 0]; xv.y += gv.y * v[c * 4 + 1]; xv.z += gv.z * v[c * 4 + 2]; xv.w += gv.w * v[c * 4 + 3];
      *(float4*)(xp + c * 4) = xv;
    }
  }
};
DI void rope16_pair(float* a, float* b, const float* cr, const float* sr, int i0) {
#pragma unroll
  for (int i = 0; i < 8; ++i) { const float c = cr[i0 + i], s = sr[i0 + i], u = a[i], w = b[i]; a[i] = u * c - w * s; b[i] = u * s + w * c; }
}
struct EpiQup {
  static constexpr bool WHOLE = false; static constexpr bool PRE = false;
  u16* proj; const float* gq; const float* cosR; const float* sinR; const float* qdss;
  DI void operator()(int row, int col, const float* v) const {
    const int head = col >> 7, cs = (col & 127) >> 5;
    const float2 qs = *(const float2*)(qdss + (size_t)row * 2);
    float ss = 0.f;
#pragma unroll
    for (int c = 0; c < 8; ++c) { const float4 t = *(const float4*)(v + c * 4); ss += t.x * t.x + t.y * t.y + t.z * t.z + t.w * t.w; }
    ss += shx<1>(ss); ss += shx<2>(ss);
    const float rq = rsqrtf((qs.x + qs.y) * (1.f / 256.f) + EPS);
    const float r = rsqrtf(ss * rq * rq * (1.f / 96.f) + EPS) * rq * (0.10206207261596575f * LOG2E);
    if (cs < 3) {
      const float* g = gq + cs * 32;
      u16* dst = proj + (size_t)row * PLD + C_MLAQ + head * 96 + cs * 32;
      const bool rope = (cs == 2) && (row >= NCTX);
      const int pos = (row - NCTX) & 2047;
      const float* cr = cosR + pos * 16; const float* sr = sinR + pos * 16;
#pragma unroll
      for (int c = 0; c < 2; ++c) {
        float a[8], b[8];
#pragma unroll
        for (int j = 0; j < 8; ++j) { a[j] = v[c * 8 + j] * r * g[c * 8 + j]; b[j] = v[16 + c * 8 + j] * r * g[16 + c * 8 + j]; }
        if (rope) rope16_pair(a, b, cr, sr, c * 8);
        *(uint4*)(dst + c * 8) = pack8(a);
        *(uint4*)(dst + 16 + c * 8) = pack8(b);
      }
    }
  }
};
struct EpiKvup {
  static constexpr bool WHOLE = false; static constexpr bool PRE = false;
  u16* mk; u16* mv; const float* kpeb; const float* gk; const float* cosR; const float* sinR;
  DI void operator()(int row, int col, const float* v) const {
    const int head = col >> 7, cs = (col & 127) >> 5;
    const float* kp = kpeb + (size_t)row * 32;
    float ss = 0.f;
    if (cs < 2) {
#pragma unroll
      for (int c = 0; c < 8; ++c) { const float4 t = *(const float4*)(v + c * 4); ss += t.x * t.x + t.y * t.y + t.z * t.z + t.w * t.w; }
    } else if (cs == 2) {
#pragma unroll
      for (int c = 0; c < 8; ++c) { const float4 t = *(const float4*)(kp + c * 4); ss += t.x * t.x + t.y * t.y + t.z * t.z + t.w * t.w; }
    }
    ss += shx<1>(ss); ss += shx<2>(ss);
    const float r = rsqrtf(ss * (1.f / 96.f) + EPS);
    if (cs <= 2) {
      const float* g = gk + cs * 32;
      bool rope = false; int pos = 0;
      if (cs == 2 && row >= NCTX) { const int kp = (row - NCTX) % SLAT; rope = kp >= PAST; pos = kp - PAST; }
      const float* cr = cosR + pos * 16; const float* sr = sinR + pos * 16;
      u16* dst = mk + (size_t)row * 768 + head * 96 + cs * 32;
#pragma unroll
      for (int c = 0; c < 2; ++c) {
        float a[8], b[8];
#pragma unroll
        for (int j = 0; j < 8; ++j) {
          const float s0 = cs == 2 ? kp[c * 8 + j] : v[c * 8 + j], s1 = cs == 2 ? kp[16 + c * 8 + j] : v[16 + c * 8 + j];
          a[j] = s0 * r * g[c * 8 + j]; b[j] = s1 * r * g[16 + c * 8 + j]; }
        if (rope) rope16_pair(a, b, cr, sr, c * 8);
        *(uint4*)(dst + c * 8) = pack8(a);
        *(uint4*)(dst + 16 + c * 8) = pack8(b);
      }
    }
    if (cs >= 2) {
      u16* dst = mv + (size_t)row * 512 + head * 64 + (cs - 2) * 32;
#pragma unroll
      for (int c = 0; c < 4; ++c) { float y[8];
#pragma unroll
        for (int j = 0; j < 8; ++j) y[j] = v[c * 8 + j];
        *(uint4*)(dst + c * 8) = pack8(y); }
    }
  }
};


DI void st32bf(u16* dst, const float* y) {
#pragma unroll
  for (int c = 0; c < 4; ++c) *(uint4*)(dst + c * 8) = pack8(y + c * 8);
}
DI void st32f(float* dst, const float* y) {
#pragma unroll
  for (int c = 0; c < 8; ++c) *(float4*)(dst + c * 4) = make_float4(y[c * 4], y[c * 4 + 1], y[c * 4 + 2], y[c * 4 + 3]);
}
DI void headnorm32(const float* v, const float* gain, int hh, bool rope, const float* cr, const float* sr, float scale, u16* dbf, float* df32) {
  float4 c4[8], s4[8];
  if (rope) {
#pragma unroll
    for (int c = 0; c < 8; ++c) { c4[c] = *(const float4*)(cr + c * 4); s4[c] = *(const float4*)(sr + c * 4); }
  }
  float ss = 0.f;
#pragma unroll
  for (int c = 0; c < 8; ++c) { const float4 t = *(const float4*)(v + c * 4); ss += t.x * t.x + t.y * t.y + t.z * t.z + t.w * t.w; }
  ss += shx<1>(ss);
  const float r = rsqrtf(ss * (1.f / 64.f) + EPS);
  const float* g = gain + hh * 32;
#pragma unroll
  for (int c = 0; c < 4; ++c) {
    float y[8];
#pragma unroll
    for (int j = 0; j < 8; ++j) y[j] = v[c * 8 + j] * r * g[c * 8 + j];
    if (rope) {
      float pv[8];
#pragma unroll
      for (int j = 0; j < 8; ++j) pv[j] = shx<1>(y[j]);
      const float cs[8] = {c4[2*c].x, c4[2*c].y, c4[2*c].z, c4[2*c].w, c4[2*c+1].x, c4[2*c+1].y, c4[2*c+1].z, c4[2*c+1].w};
      const float sn[8] = {s4[2*c].x, s4[2*c].y, s4[2*c].z, s4[2*c].w, s4[2*c+1].x, s4[2*c+1].y, s4[2*c+1].z, s4[2*c+1].w};
#pragma unroll
      for (int j = 0; j < 8; ++j) y[j] = hh == 0 ? (y[j] * cs[j] - pv[j] * sn[j]) : (pv[j] * sn[j] + y[j] * cs[j]);
    }
#pragma unroll
    for (int j = 0; j < 8; ++j) y[j] *= scale;
    *(uint4*)(dbf + c * 8) = pack8(y);
    if (df32) st8f(df32 + c * 8, y);
  }
}
DI void copy32(const float* v, u16* dbf, float* df32) {
#pragma unroll
  for (int c = 0; c < 4; ++c) {
    float y[8];
#pragma unroll
    for (int j = 0; j < 8; ++j) y[j] = v[c * 8 + j];
    *(uint4*)(dbf + c * 8) = pack8(y);
    if (df32) st8f(df32 + c * 8, y);
  }
}
struct EpiProj2 {
  static constexpr bool WHOLE = false; static constexpr bool PRE = false;
  u16* proj; u16* dk; u16* dv; u16* gk; u16* gv; u16* ckvn; float* kpeb; float* qdss; float* out;
  const float* g_dqk; const float* g_mq; const float* g_mkv; const float* g_gqk; const float* cosH; const float* sinH; int l;
  DI void operator()(int row, int col, const float* v) const {
    if (col >= C_GATE) {
      u16* dst = proj + (size_t)row * PLD + col;
#pragma unroll
      for (int c = 0; c < 4; ++c) { float x[8];
#pragma unroll
        for (int j = 0; j < 8; ++j) x[j] = sigmoidf(v[c * 8 + j]);
        *(uint4*)(dst + c * 8) = pack8(x); }
      return;
    }
    const bool ctx = row < NCTX;
    int kvrow, pos; size_t orow = 0;
    if (ctx) { kvrow = row; pos = 0; orow = ((size_t)(row >> 8) * 4 + l) * 256 + (row & 255); }
    else { const int s = (row - NCTX) >> 11; pos = (row - NCTX) & 2047; kvrow = NCTX + s * SLAT + PAST + pos; }
    const float* cr = cosH + pos * 32; const float* sr = sinH + pos * 32;
    const int hh = (col >> 5) & 1;
    if (col < C_AK) {
      headnorm32(v, g_dqk, hh, !ctx, cr, sr, 0.125f * LOG2E, proj + (size_t)row * PLD + col, nullptr);
    } else if (col < C_AV) {
      headnorm32(v, g_dqk + 64, hh, !ctx, cr, sr, 1.f, dk + (size_t)kvrow * 512 + (col - C_AK), ctx ? out + O_NDK + orow * 512 + (col - C_AK) : nullptr);
    } else if (col < C_BQD) {
      copy32(v, dv + (size_t)kvrow * 512 + (col - C_AV), ctx ? out + O_NDV + orow * 512 + (col - C_AV) : nullptr);
    } else if (col < C_CQ) {
      float ss = 0.f;
#pragma unroll
      for (int c = 0; c < 8; ++c) { const float4 t = *(const float4*)(v + c * 4); ss += t.x * t.x + t.y * t.y + t.z * t.z + t.w * t.w; }
      ss += shx<1>(ss); ss += shx<2>(ss);
      if ((col & 127) == 0) qdss[(size_t)row * 2 + ((col - C_BQD) >> 7)] = ss;
      const float* g = g_mq + (col - C_BQD);
      u16* dst = proj + (size_t)row * PLD + col;
#pragma unroll
      for (int c = 0; c < 4; ++c) { float y[8];
#pragma unroll
        for (int j = 0; j < 8; ++j) y[j] = v[c * 8 + j] * g[c * 8 + j];
        *(uint4*)(dst + c * 8) = pack8(y); }
    } else if (col < C_CK) {
      headnorm32(v, g_gqk, hh, !ctx, cr, sr, 0.125f * LOG2E, proj + (size_t)row * PLD + col, nullptr);
    } else if (col < C_CV) {
      headnorm32(v, g_gqk + 64, hh, !ctx, cr, sr, 1.f, gk + (size_t)kvrow * 128 + (col - C_CK), ctx ? out + O_NGK + orow * 128 + (col - C_CK) : nullptr);
    } else if (col < C_CKV) {
      copy32(v, gv + (size_t)kvrow * 128 + (col - C_CV), ctx ? out + O_NGV + orow * 128 + (col - C_CV) : nullptr);
    } else if (col < C_KPE) {
      float ss = 0.f;
#pragma unroll
      for (int c = 0; c < 8; ++c) { const float4 t = *(const float4*)(v + c * 4); ss += t.x * t.x + t.y * t.y + t.z * t.z + t.w * t.w; }
      ss += shx<1>(ss); ss += shx<2>(ss);
      const float r = rsqrtf(ss * (1.f / 128.f) + EPS);
      const float* g = g_mkv + (col - C_CKV);
      u16* dst = ckvn + (size_t)kvrow * 256 + (col - C_CKV);
      unsigned zz = 0u; asm volatile("" : "+v"(zz));
#pragma unroll
      for (int c = 0; c < 4; ++c) { float y[8], w[8];
#pragma unroll
        for (int j = 0; j < 8; ++j) { w[j] = v[c * 8 + j]; y[j] = w[j] * r * g[c * 8 + j]; }
        *(uint4*)(dst + c * 8) = pack8(y);
        *(uint4*)(dst + 128 + c * 8) = make_uint4(zz, zz, zz, zz);
        if (ctx) st8f(out + O_NCKV + orow * 128 + (col - C_CKV) + c * 8, w); }
    } else if (col == C_KPE) {
#pragma unroll
      for (int c = 0; c < 4; ++c) { float w[8];
#pragma unroll
        for (int j = 0; j < 8; ++j) w[j] = v[c * 8 + j];
        st8f(kpeb + (size_t)kvrow * 32 + c * 8, w);
        if (ctx) st8f(out + O_NKPE + orow * 32 + c * 8, w); }
    }
  }
};

DI void conv8(const float* xm, const float* x0, const float* xp, const float* ym, const float* y0, const float* yp,
              const float* wa0, const float* wa1, const float* wa2, const float* ba, const float* wg0, const float* wg1, const float* wg2, const float* bg, float* o) {
#pragma unroll
  for (int q = 0; q < 8; ++q) {
    const float av = xm[q] * wa0[q] + x0[q] * wa1[q] + xp[q] * wa2[q] + ba[q];
    const float gv = ym[q] * wg0[q] + y0[q] * wg1[q] + yp[q] * wg2[q] + bg[q];
    o[q] = av * siluf(gv);
  }
}
struct EpiConv {
  static constexpr bool WHOLE = true; static constexpr bool PRE = false;
  static constexpr int TLD = 264;
  u16* act; u16* halo; const float* cw; const float* cb;
  DI void whole(f32x4 (&acc)[2][2][4][2], int brow, int bcol, char* smem, int tid) const {
    u16* tl = (u16*)smem;
    const int wid = tid >> 6, lane = tid & 63, wr = wid >> 2, wc = wid & 3, fr = lane & 15, fq = lane >> 4;
    const int pm = brow >> 8, pn = bcol >> 8;
    const bool lat = brow >= NCTX;
    const int c = tid & 15, r0 = tid >> 4;
    const int jg = pn * 128 + c * 8;
    float wa0[8], wa1[8], wa2[8], ba[8], wg0[8], wg1[8], wg2[8], bg[8];
    ld8f(cw + jg, wa0); ld8f(cw + UP + jg, wa1); ld8f(cw + 2 * UP + jg, wa2); ld8f(cb + jg, ba);
    ld8f(cw + DFF + jg, wg0); ld8f(cw + UP + DFF + jg, wg1); ld8f(cw + 2 * UP + DFF + jg, wg2); ld8f(cb + DFF + jg, bg);
#pragma unroll
    for (int ai = 0; ai < 2; ++ai)
#pragma unroll
      for (int bj = 0; bj < 2; ++bj)
#pragma unroll
        for (int m = 0; m < 4; ++m)
#pragma unroll
          for (int n = 0; n < 2; ++n)
#pragma unroll
            for (int j = 0; j < 4; ++j)
              tl[(ai * 128 + wr * 64 + m * 16 + fq * 4 + j) * TLD + bj * 128 + wc * 32 + n * 16 + fr] = (u16)(pk2(acc[ai][bj][m][n][j], 0.f) & 0xffffu);
    __syncthreads();
    const uint4 z4 = make_uint4(0, 0, 0, 0);
#pragma unroll 2
    for (int k = 0; k < 8; ++k) {
      const int r = r0 + 32 * k;
      if (lat && (r == 0 || r == 255)) continue;
      const u16* base = tl + r * TLD + c * 8;
      const uint4 am = r > 0 ? *(const uint4*)(base - TLD) : z4, gm = r > 0 ? *(const uint4*)(base - TLD + 128) : z4;
      const uint4 a0 = *(const uint4*)base, g0 = *(const uint4*)(base + 128);
      const uint4 ap = r < 255 ? *(const uint4*)(base + TLD) : z4, gp = r < 255 ? *(const uint4*)(base + TLD + 128) : z4;
      float xm[8], x0[8], xp[8], ym[8], y0[8], yp[8], o[8];
      unpack8(am, xm); unpack8(a0, x0); unpack8(ap, xp); unpack8(gm, ym); unpack8(g0, y0); unpack8(gp, yp);
      conv8(xm, x0, xp, ym, y0, yp, wa0, wa1, wa2, ba, wg0, wg1, wg2, bg, o);
      *(uint4*)(act + (size_t)(brow + r) * DFF + jg) = pack8(o);
    }
    if (lat && tid < 128) {
      const int rs = tid >> 5, ch = tid & 31;
      const int row = rs < 2 ? rs : 252 + rs;
      *(uint4*)(halo + ((size_t)((pm - 32) * 22 + pn) * 4 + rs) * 256 + ch * 8) = *(const uint4*)(tl + row * TLD + ch * 8);
    }
    __syncthreads();
  }
  DI void operator()(int, int, const float*) const {}
};
DI void conv_fixup(u16* act, const u16* halo, const float* cw, const float* cb, int pm, int tid) {
  if (pm < 32) return;
  const int lm = pm - 32;
  for (int it = tid; it < 704; it += 512) {
    const int rsel = it / 352, j = (it % 352) * 8, pn = j >> 7, jj = j & 127;
    const u16* hb = halo + (size_t)(lm * 22 + pn) * 1024;
    const uint4 z4 = make_uint4(0, 0, 0, 0);
    uint4 am, gm, a0, g0, ap, gp;
    if (rsel == 0) {
      const bool first = (lm & 7) == 0;
      const u16* hp = halo + (size_t)((lm - 1) * 22 + pn) * 1024 + 3 * 256;
      am = first ? z4 : *(const uint4*)(hp + jj); gm = first ? z4 : *(const uint4*)(hp + 128 + jj);
      a0 = *(const uint4*)(hb + jj); g0 = *(const uint4*)(hb + 128 + jj);
      ap = *(const uint4*)(hb + 256 + jj); gp = *(const uint4*)(hb + 256 + 128 + jj);
    } else {
      const bool last = (lm & 7) == 7;
      const u16* hn = halo + (size_t)((lm + 1) * 22 + pn) * 1024;
      am = *(const uint4*)(hb + 512 + jj); gm = *(const uint4*)(hb + 512 + 128 + jj);
      a0 = *(const uint4*)(hb + 768 + jj); g0 = *(const uint4*)(hb + 768 + 128 + jj);
      ap = last ? z4 : *(const uint4*)(hn + jj); gp = last ? z4 : *(const uint4*)(hn + 128 + jj);
    }
    float wa0[8], wa1[8], wa2[8], ba[8], wg0[8], wg1[8], wg2[8], bg[8];
    ld8f(cw + j, wa0); ld8f(cw + UP + j, wa1); ld8f(cw + 2 * UP + j, wa2); ld8f(cb + j, ba);
    ld8f(cw + DFF + j, wg0); ld8f(cw + UP + DFF + j, wg1); ld8f(cw + 2 * UP + DFF + j, wg2); ld8f(cb + DFF + j, bg);
    float xm[8], x0[8], xp[8], ym[8], y0[8], yp[8], o[8];
    unpack8(am, xm); unpack8(a0, x0); unpack8(ap, xp); unpack8(gm, ym); unpack8(g0, y0); unpack8(gp, yp);
    conv8(xm, x0, xp, ym, y0, yp, wa0, wa1, wa2, ba, wg0, wg1, wg2, bg, o);
    *(uint4*)(act + (size_t)(pm * 256 + (rsel ? 255 : 0)) * DFF + j) = pack8(o);
  }
}
struct NoPre { DI void operator()(int, int, int) const {} };
struct PreCkv {
  const float* cckv; const float* ckpe; const float* g_mkv; u16* ckvn; float* kpeb; int l;
  DI void operator()(int pm, int, int tid) const {
    const int s = (pm - 32) / 9, lane = tid & 63, w = tid >> 6;
#pragma unroll 2
    for (int it = 0; it < 32; ++it) {
      const int kp = w + 8 * it, kvrow = NCTX + s * SLAT + kp;
      const size_t crow = (size_t)(s * 4 + l) * 256 + kp;
      float x[8]; float ss = 0.f;
      if (lane < 16) { ld8f(cckv + crow * 128 + lane * 8, x);
#pragma unroll
        for (int j = 0; j < 8; ++j) ss += x[j] * x[j]; }
      ss = wave_sum(ss);
      const float rr = rsqrtf(ss * (1.f / 128.f) + EPS);
      if (lane < 16) {
#pragma unroll
        for (int j = 0; j < 8; ++j) x[j] = x[j] * rr * g_mkv[lane * 8 + j];
        *(uint4*)(ckvn + (size_t)kvrow * 256 + lane * 8) = pack8(x);
      } else if (lane < 32) {
        unsigned zz = 0u; asm volatile("" : "+v"(zz)); *(uint4*)(ckvn + (size_t)kvrow * 256 + lane * 8) = make_uint4(zz, zz, zz, zz);
      }
      if (lane < 4) { ld8f(ckpe + crow * 32 + lane * 8, x); st8f(kpeb + (size_t)kvrow * 32 + lane * 8, x); }
    }
  }
};
struct PreNorm {
  u16* h; const float* gain; const float* modl; int shoff; int scoff; const float* src0; const float* src1; int last;
  DI void operator()(int pm, int, int tid) {
    if (pm == last) return;
    last = pm;
    const int lane = tid & 63, w = tid >> 6;
    float4 g4[4];
#pragma unroll
    for (int i = 0; i < 4; ++i) g4[i] = *(const float4*)(gain + i * 256 + lane * 4);
    const float* md = modl + tok_group(pm * 256) * 6144;
    float4 sc[4], sh[4];
#pragma unroll
    for (int i = 0; i < 4; ++i) { const int c = i * 256 + lane * 4; sc[i] = *(const float4*)(md + scoff + c); sh[i] = *(const float4*)(md + shoff + c); }
    for (int it = 0; it < 32; it += 4) {
      float4 v[4][4]; float ss[4];
#pragma unroll
      for (int q = 0; q < 4; ++q) {
        const int t = pm * 256 + w + 8 * (it + q);
        const float* xr = t < NCTX ? src0 + (size_t)t * 1024 : src1 + (size_t)(t - NCTX) * 1024;
#pragma unroll
        for (int i = 0; i < 4; ++i) v[q][i] = *(const float4*)(xr + i * 256 + lane * 4);
      }
#pragma unroll
      for (int q = 0; q < 4; ++q) {
        float s = 0.f;
#pragma unroll
        for (int i = 0; i < 4; ++i) s += v[q][i].x*v[q][i].x + v[q][i].y*v[q][i].y + v[q][i].z*v[q][i].z + v[q][i].w*v[q][i].w;
        ss[q] = s;
      }
#pragma unroll
      for (int q = 0; q < 4; ++q) ss[q] += shx<32>(ss[q]);
#pragma unroll
      for (int q = 0; q < 4; ++q) ss[q] += shx<16>(ss[q]);
#pragma unroll
      for (int q = 0; q < 4; ++q) ss[q] += shx<8>(ss[q]);
#pragma unroll
      for (int q = 0; q < 4; ++q) ss[q] += shx<4>(ss[q]);
#pragma unroll
      for (int q = 0; q < 4; ++q) ss[q] += shx<2>(ss[q]);
#pragma unroll
      for (int q = 0; q < 4; ++q) ss[q] += shx<1>(ss[q]);
#pragma unroll
      for (int q = 0; q < 4; ++q) {
        const int t = pm * 256 + w + 8 * (it + q);
        const float r = rsqrtf(ss[q] * (1.f / 1024.f) + EPS);
#pragma unroll
        for (int i = 0; i < 4; ++i) {
          const int c = i * 256 + lane * 4;
          const float4 g = g4[i];
          const float y0 = v[q][i].x * r * g.x * (1.f + sc[i].x) + sh[i].x, y1 = v[q][i].y * r * g.y * (1.f + sc[i].y) + sh[i].y;
          const float y2 = v[q][i].z * r * g.z * (1.f + sc[i].z) + sh[i].z, y3 = v[q][i].w * r * g.w * (1.f + sc[i].w) + sh[i].w;
          uint2 o; o.x = pk2(y0, y1); o.y = pk2(y2, y3);
          *(uint2*)(h + (size_t)t * 1024 + c) = o;
        }
      }
    }
  }
};
struct PreFix { u16* act; const u16* halo; const float* cw; const float* cb; DI void operator()(int pm, int, int tid) const { conv_fixup(act, halo, cw, cb, pm, tid); } };


constexpr int GLD = 264;
DI void gate_half_to_lds(const u16* __restrict__ proj, int gi, int brow, int bcol, int ai, u16* dst, int tid) {
  const u16* g = proj + (size_t)(brow + ai * 128) * PLD + C_GATE + gi * 1024 + bcol;
  int t = tid; asm volatile("" : "+v"(t));
  const unsigned off = (unsigned)((t >> 5) * PLD + (t & 31) * 8);
  const unsigned lo = (unsigned)((t >> 5) * GLD + (t & 31) * 8);
#pragma unroll
  for (int k2 = 0; k2 < 2; ++k2) {
    const uint4 v0 = *(const uint4*)(g + (size_t)(off + (unsigned)((k2 * 4 + 0) * 16 * PLD)));
    const uint4 v1 = *(const uint4*)(g + (size_t)(off + (unsigned)((k2 * 4 + 1) * 16 * PLD)));
    const uint4 v2 = *(const uint4*)(g + (size_t)(off + (unsigned)((k2 * 4 + 2) * 16 * PLD)));
    const uint4 v3 = *(const uint4*)(g + (size_t)(off + (unsigned)((k2 * 4 + 3) * 16 * PLD)));
    *(uint4*)(dst + lo + (k2 * 4 + 0) * 16 * GLD) = v0;
    *(uint4*)(dst + lo + (k2 * 4 + 1) * 16 * GLD) = v1;
    *(uint4*)(dst + lo + (k2 * 4 + 2) * 16 * GLD) = v2;
    *(uint4*)(dst + lo + (k2 * 4 + 3) * 16 * GLD) = v3;
    __builtin_amdgcn_sched_barrier(0);
  }
}
DI void scale_acc(f32x4 (&acc)[2][2][4][2], const u16* proj, int gnum, int gden, int brow, int bcol, char* smem, int tid) {
  u16* l0 = (u16*)smem; u16* l1 = l0 + 128 * GLD;
#pragma unroll
  for (int ai = 0; ai < 2; ++ai) {
    if (gnum >= 0) gate_half_to_lds(proj, gnum, brow, bcol, ai, l0, tid);
    if (gden >= 0) gate_half_to_lds(proj, gden, brow, bcol, ai, l1, tid);
    __syncthreads();
    int t = tid; asm volatile("" : "+v"(t));
    const int wid = t >> 6, lane = t & 63, wr = wid >> 2, wc = wid & 3, fr = lane & 15, fq = lane >> 4;
    unsigned b0 = (unsigned)(((wr * 64 + fq * 4) * GLD + wc * 32 + fr) * 2);
    unsigned b1 = b0 + 128u * GLD * 2u;
    asm volatile("" : "+v"(b0), "+v"(b1));
#pragma unroll
    for (int bj = 0; bj < 2; ++bj)
#pragma unroll
      for (int m = 0; m < 4; ++m) {
#pragma unroll
        for (int n = 0; n < 2; ++n)
#pragma unroll
          for (int j = 0; j < 4; ++j) {
            const int co = ((m * 16 + j) * GLD + bj * 128 + n * 16) * 2;
            float f = 1.f;
            if (gnum >= 0) f = fmaxf(bf2f(*(const u16*)(smem + b0 + co)), 1e-6f);
            if (gden >= 0) f = f * __builtin_amdgcn_rcpf(fmaxf(bf2f(*(const u16*)(smem + b1 + co)), 1e-6f));
            acc[ai][bj][m][n][j] *= f;
          }
        asm volatile("" : "+v"(acc[ai][bj][m][0]), "+v"(acc[ai][bj][m][1]));
      }
    __syncthreads();
  }
}
DI void merge_tile(const u16* ob, const u16* wb, const u16* proj, u16* hb, int brow, int bcol, char* smem) {
  f32x4 acc[2][2][4][2];
  gemm_kloop<true>(ob, 1536, wb, 512, 512, brow, bcol, smem, acc, otid());
  scale_acc(acc, proj, 0, 1, brow, bcol, smem, otid());
  gemm_kloop<false>(ob + 512, 1536, wb + (size_t)1024 * 512, 512, 512, brow, bcol, smem, acc, otid());
  scale_acc(acc, proj, 1, 2, brow, bcol, smem, otid());
  gemm_kloop<false>(ob + 1024, 1536, wb + (size_t)2 * 1024 * 512, 512, 512, brow, bcol, smem, acc, otid());
  scale_acc(acc, proj, 2, -1, brow, bcol, smem, otid());
  const int tid = otid();
  u16* tl = (u16*)smem;
  int t2 = tid; asm volatile("" : "+v"(t2));
  const int wid = t2 >> 6, lane = t2 & 63, wr = wid >> 2, wc = wid & 3, fr = lane & 15, fq = lane >> 4;
#pragma unroll
  for (int ai = 0; ai < 2; ++ai)
#pragma unroll
    for (int bj = 0; bj < 2; ++bj)
#pragma unroll
      for (int m = 0; m < 4; ++m)
#pragma unroll
        for (int n = 0; n < 2; ++n)
#pragma unroll
          for (int j = 0; j < 4; ++j)
            tl[(ai * 128 + wr * 64 + m * 16 + fq * 4 + j) * GLD + bj * 128 + wc * 32 + n * 16 + fr] = (u16)(pk2(acc[ai][bj][m][n][j], 0.f) & 0xffffu);
  __syncthreads();
#pragma unroll
  for (int k = 0; k < 16; ++k) {
    const int id = tid + 512 * k, row = id >> 5, ch = id & 31;
    *(uint4*)(hb + (size_t)(brow + row) * 1024 + bcol + ch * 8) = *(const uint4*)(tl + row * GLD + ch * 8);
  }
  __syncthreads();
}
DI void merge_phase(const u16* ob, const u16* wb, const u16* proj, u16* hb, char* smem, int vb) {
  const int nb = ogrid();
  const int nx = nb >> 5;
  int team, rnk, nteam, tsz;
  if (nx * 32 == nb) { team = vb >> 5; rnk = vb & 31; nteam = nx; tsz = 32; } else { team = 0; rnk = vb; nteam = 1; tsz = nb; }
  const int lo = (256 * team) / nteam, hi = (256 * (team + 1)) / nteam;
  for (int t = lo + rnk; t < hi; t += tsz) {
    const int g = t >> 5, w = t & 31;
    const int pm = g * 8 + (w & 7), pn = w >> 3;
    merge_tile(ob, wb, proj, hb, pm * BM, pn * BM, smem);
  }
}

template <class Epi, class Pre = NoPre, int MAP = 0>
DI void gemm_phase(const u16* A, int lda, const u16* Bt, int ldb, int K, int nM, int nN, char* smem, Epi& epi, int tile0, int ntot, int vb, Pre pre = Pre()) {
  const int nb = ogrid();
  const int nx = nb >> 5;
  int team, rnk, nteam, tsz;
  if (nx * 32 == nb) { team = vb >> 5; rnk = vb & 31; nteam = nx; tsz = 32; } else { team = 0; rnk = vb; nteam = 1; tsz = nb; }
  const int lo = __builtin_amdgcn_readfirstlane((ntot * team) / nteam), hi = __builtin_amdgcn_readfirstlane((ntot * (team + 1)) / nteam);
  for (int t = lo + rnk; t < hi; t += tsz) {
    const int tt = t - tile0;
    if (tt < 0 || tt >= nM * nN) continue;
    const int gsz8 = 8 * nN, g = __builtin_amdgcn_readfirstlane(tt / gsz8), w = tt - g * gsz8;
    const int gm = min(8, nM - g * 8);
    const int pn = __builtin_amdgcn_readfirstlane(w / gm); int pm = g * 8 + (w - pn * gm);
    if (MAP == 1) pm = pm < 32 ? pm : 32 + 9 * ((pm - 32) >> 3) + 1 + ((pm - 32) & 7);
    if (MAP == 2) pm = 32 + 9 * pm;
    pre(pm, pn, otid());
    gemm_tile(A, lda, Bt, ldb, K, pm * BM, pn * BM, smem, epi);
  }
}

DI void convT(const float* __restrict__ src, int K, int N, u16* __restrict__ dst, int Nd, int Kd, int mode, char* smem, int rot) {
  float* t = (float*)smem;
  const int tn = Nd >> 6, tk = Kd >> 6, ntile = tn * tk;
  const int tid = otid();
  const int nb_ = ogrid();
  int tt0 = obid() + rot; if (tt0 >= nb_) tt0 -= nb_;
  for (int tt = tt0; tt < ntile; tt += nb_) {
    const int n0 = (tt % tn) << 6, k0 = (tt / tn) << 6;
    __syncthreads();
    {
      const int kr = tid >> 4, nc = (tid & 15) * 4;
      const int nd = n0 + nc;
      int sn;
      if (mode == 0) sn = nd < N ? nd : -1;
      else if (mode == 1) { const int hh = nd >> 7, j = nd & 127; sn = j < 96 ? hh * 96 + j : -1; }
      else if (mode == 3) sn = nd < 1792 ? nd : nd < 2560 ? nd + 160 : nd < 2720 ? nd - 768 : nd < 2816 ? -1 : nd - 96;
      else sn = ((nd & 255) >> 7) * DFF + (nd >> 8) * 128 + (nd & 127);
      float4 v0 = make_float4(0.f, 0.f, 0.f, 0.f), v1 = v0;
      if (sn >= 0) {
        if (k0 + kr < K) v0 = *(const float4*)(src + (size_t)(k0 + kr) * N + sn);
        if (k0 + kr + 32 < K) v1 = *(const float4*)(src + (size_t)(k0 + kr + 32) * N + sn);
      }
      float* t0 = t + kr * 65 + nc; float* t1 = t + (kr + 32) * 65 + nc;
      t0[0] = v0.x; t0[1] = v0.y; t0[2] = v0.z; t0[3] = v0.w;
      t1[0] = v1.x; t1[1] = v1.y; t1[2] = v1.z; t1[3] = v1.w;
    }
    __syncthreads();
    {
      const int nr = tid >> 3, kc = (tid & 7) * 8;
      float x[8];
#pragma unroll
      for (int j = 0; j < 8; ++j) x[j] = t[(kc + j) * 65 + nr];
      *(uint4*)(dst + (size_t)(n0 + nr) * Kd + k0 + kc) = pack8(x);
    }
  }
}

DI void convert_layer(const Params& p, int l, char* smem) {
  char* ws = ows(p.ws);
  convT(p.in[13] + (size_t)l * 1024 * IN_COLS, 1024, IN_COLS, (u16*)(ws + WS_WIN), PLD, 1024, 3, smem, 0);
  convT(p.in[28] + (size_t)l * 1024 * UP, 1024, UP, (u16*)(ws + WS_WUP), UP, 1024, 2, smem, 64);
  convT(p.in[31] + (size_t)l * DFF * 1024, DFF, 1024, (u16*)(ws + WS_WD), 1024, DFF, 0, smem, 192);
  convT(p.in[26] + (size_t)l * 1024 * 1024, 1024, 1024, (u16*)(ws + WS_WO), 1024, 1024, 0, smem, 128);
  convT(p.in[23] + (size_t)l * 512 * 1024, 512, 1024, (u16*)(ws + WS_WB), 1024, 512, 0, smem, 0);
  convT(p.in[24] + (size_t)l * 512 * 1024, 512, 1024, (u16*)(ws + WS_WB) + 1024 * 512, 1024, 512, 0, smem, 128);
  convT(p.in[25] + (size_t)l * 512 * 1024, 512, 1024, (u16*)(ws + WS_WB) + 2 * 1024 * 512, 1024, 512, 0, smem, 0);
  convT(p.in[18] + (size_t)l * 256 * 768, 256, 768, (u16*)(ws + WS_WQU), 1024, 256, 1, smem, 128);
  convT(p.in[20] + (size_t)l * 128 * 1024, 128, 1024, (u16*)(ws + WS_WKV), 1024, 256, 0, smem, 192);
}

DI void phase0(const Params& p, char* smem) {
  const int bid_ = obid(), nb_ = ogrid();
  const int tid = otid(), gtid = bid_ * 512 + tid, nth = nb_ * 512;
  char* ws = ows(p.ws);
  {
    float* rp = (float*)(ws + WS_ROPE);
    for (int i = gtid; i < 2048 * 48; i += nth) {
      int pos, j, quarter; float* cd; float* sd;
      if (i < 2048 * 32) { pos = i >> 5; j = i & 31; quarter = 16; cd = rp + i; sd = rp + 65536 + i; }
      else { int k = i - 65536; pos = k >> 4; j = k & 15; quarter = 8; cd = rp + 131072 + k; sd = rp + 131072 + 32768 + k; }
      const int row = pos >> 6, colp = pos & 63;
      const int jj = j < quarter ? j : j - quarter;
      const float inv = 1.0f / exp2f((float)jj / (float)quarter * 13.287712379549449f);
      const float ang = (float)(j < quarter ? row : colp) * inv;
      const float rev = ang * 0.15915494309189535f;
      const float fr = rev - rintf(rev);
      const double a2 = (double)ang - (double)rintf(rev) * 6.283185307179586;
      (void)fr;
      *cd = __cosf((float)a2); *sd = __sinf((float)a2);
    }
  }
  {
    float* sc = (float*)smem;
    float* modp = (float*)(ws + WS_MODP);
    for (int it = bid_; it < 4 * 12 * 16; it += nb_) {
      const int l = it / 192, cc = (it / 16) % 12, kc = it & 15;
      __syncthreads();
      if (tid < 5 * 64) {
        const int g = tid >> 6, k = kc * 64 + (tid & 63);
        const float cv = g == 0 ? p.in[9][k] : p.in[2][(g - 1) * 1024 + k];
        sc[tid] = siluf(cv);
      }
      __syncthreads();
      const int n = cc * 512 + tid;
      const float* w = p.in[10] + ((size_t)l * 1024 + kc * 64) * 6144 + n;
      float a0 = 0, a1 = 0, a2 = 0, a3 = 0, a4 = 0;
#pragma unroll
      for (int kb = 0; kb < 4; ++kb) {
        float wv[16];
#pragma unroll
        for (int k = 0; k < 16; ++k) wv[k] = w[(size_t)(kb * 16 + k) * 6144];
#pragma unroll
        for (int k = 0; k < 16; ++k) {
          const int kk = kb * 16 + k;
          a0 += sc[kk] * wv[k]; a1 += sc[64 + kk] * wv[k]; a2 += sc[128 + kk] * wv[k]; a3 += sc[192 + kk] * wv[k]; a4 += sc[256 + kk] * wv[k];
        }
      }
      float* o = modp + ((size_t)(kc * 4 + l) * 5) * 6144 + n;
      o[0] = a0; o[6144] = a1; o[2 * 6144] = a2; o[3 * 6144] = a3; o[4 * 6144] = a4;
    }
  }
}
DI void phase0b(const Params& p) {
  const int gtid = obid() * 512 + otid(), nth = ogrid() * 512;
  char* ws = ows(p.ws);
  const float* modp = (const float*)(ws + WS_MODP);
  float* mod = (float*)(ws + WS_MOD);
  for (int i = gtid; i < 4 * 5 * 6144; i += nth) {
    const int l = i / (5 * 6144), n = i % 6144;
    float s = p.in[11][l * 6144 + n];
#pragma unroll
    for (int kc = 0; kc < 16; ++kc) s += modp[(size_t)kc * 4 * 5 * 6144 + i];
    mod[i] = s;
  }
}

DI void norm_mod(const Params& p, const float* gain, const float* modl, int shoff, int scoff, const float* src0, const float* src1) {
  const int tid = otid(), lane = tid & 63;
  const int gw = (obid() * 512 + tid) >> 6, nw = (ogrid() * 512) >> 6;
  u16* h = (u16*)(ows(p.ws) + WS_H);
  for (int t = gw; t < NTOK; t += nw) {
    const float* xr = t < NCTX ? src0 + (size_t)t * 1024 : src1 + (size_t)(t - NCTX) * 1024;
    float4 v[4]; float ss = 0.f;
#pragma unroll
    for (int i = 0; i < 4; ++i) { v[i] = *(const float4*)(xr + i * 256 + lane * 4); ss += v[i].x*v[i].x + v[i].y*v[i].y + v[i].z*v[i].z + v[i].w*v[i].w; }
    ss = wave_sum(ss);
    const float r = rsqrtf(ss * (1.f / 1024.f) + EPS);
    const float* md = modl + tok_group(t) * 6144;
#pragma unroll
    for (int i = 0; i < 4; ++i) {
      const int c = i * 256 + lane * 4;
      const float4 g = *(const float4*)(gain + c), sc = *(const float4*)(md + scoff + c), sh = *(const float4*)(md + shoff + c);
      const float y0 = v[i].x * r * g.x * (1.f + sc.x) + sh.x, y1 = v[i].y * r * g.y * (1.f + sc.y) + sh.y;
      const float y2 = v[i].z * r * g.z * (1.f + sc.z) + sh.z, y3 = v[i].w * r * g.w * (1.f + sc.w) + sh.w;
      uint2 o; o.x = pk2(y0, y1); o.y = pk2(y2, y3);
      *(uint2*)(h + (size_t)t * 1024 + c) = o;
    }
  }
}

DI void headnorm_rope64(float* x, const float* gain, int lane, bool rope, const float* cr, const float* sr, float outscale) {
  float ss = 0.f;
#pragma unroll
  for (int j = 0; j < 8; ++j) ss += x[j] * x[j];
  ss += shx<1>(ss); ss += shx<2>(ss); ss += shx<4>(ss);
  const float r = rsqrtf(ss * (1.f / 64.f) + EPS);
  const int d0 = (lane & 7) * 8;
#pragma unroll
  for (int j = 0; j < 8; ++j) x[j] = x[j] * r * gain[d0 + j];
  float y[8];
#pragma unroll
  for (int j = 0; j < 8; ++j) y[j] = shx<4>(x[j]);
  if (rope) {
    const int i0 = d0 & 31;
    const bool first = (lane & 4) == 0;
#pragma unroll
    for (int j = 0; j < 8; ++j) {
      const float c = cr[i0 + j], s = sr[i0 + j];
      x[j] = first ? (x[j] * c - y[j] * s) : (y[j] * s + x[j] * c);
    }
  }
#pragma unroll
  for (int j = 0; j < 8; ++j) x[j] *= outscale;
}

DI void phase3_cached(const Params& p, int l) {
  const int tid = otid(), lane = tid & 63;
  const int gw = (obid() * 512 + tid) >> 6, nw = (ogrid() * 512) >> 6;
  char* ws = ows(p.ws);
  u16* dk = (u16*)(ws + WS_DK); u16* dv = (u16*)(ws + WS_DV);
  u16* gk = (u16*)(ws + WS_GK); u16* gv = (u16*)(ws + WS_GV);
  u16* ckvn = (u16*)(ws + WS_CKVN); float* kpeb = (float*)(ws + WS_KPE);
  const float* g_mkv = p.in[19] + l * 128;
  for (int r = NTOK + gw; r < KVROWS; r += nw) {
    {
      const int c = r - NTOK, s = c >> 8, kp = c & 255;
      const int kvrow = NCTX + s * SLAT + kp;
      const size_t crow = ((size_t)(s * 4 + l) * 256 + kp);
      float x[8];
      ld8f(p.in[3] + crow * 512 + lane * 8, x); *(uint4*)(dk + (size_t)kvrow * 512 + lane * 8) = pack8(x);
      ld8f(p.in[4] + crow * 512 + lane * 8, x); *(uint4*)(dv + (size_t)kvrow * 512 + lane * 8) = pack8(x);
      {
        float ss = 0.f;
        if (lane < 16) { ld8f(p.in[5] + crow * 128 + lane * 8, x);
#pragma unroll
          for (int j = 0; j < 8; ++j) ss += x[j] * x[j]; }
        ss = wave_sum(ss);
        const float rr = rsqrtf(ss * (1.f / 128.f) + EPS);
        if (lane < 16) {
#pragma unroll
          for (int j = 0; j < 8; ++j) x[j] = x[j] * rr * g_mkv[lane * 8 + j];
          *(uint4*)(ckvn + (size_t)kvrow * 256 + lane * 8) = pack8(x);
        } else if (lane < 32) {
          { unsigned zz = 0u; asm volatile("" : "+v"(zz)); *(uint4*)(ckvn + (size_t)kvrow * 256 + lane * 8) = make_uint4(zz, zz, zz, zz); }
        }
      }
      if (lane < 4) { ld8f(p.in[6] + crow * 32 + lane * 8, x); st8f(kpeb + (size_t)kvrow * 32 + lane * 8, x); }
      if (lane < 16) {
        ld8f(p.in[7] + crow * 128 + lane * 8, x); *(uint4*)(gk + (size_t)kvrow * 128 + lane * 8) = pack8(x);
        ld8f(p.in[8] + crow * 128 + lane * 8, x); *(uint4*)(gv + (size_t)kvrow * 128 + lane * 8) = pack8(x);
      }
    }
  }
}

DI s16x4 tr_read(const char* addr) {
  return __builtin_amdgcn_ds_read_tr16_b64_v4i16((__attribute__((address_space(3))) s16x4*)(unsigned)(size_t)addr);
}

template <int DQK, int DV, int NM>
DI void attn_item(const u16* __restrict__ Qp, int ldq, int qms, const u16* __restrict__ Kp, int ldk, int kms,
                  const u16* __restrict__ Vp, int ldv, int q0, int kv0, int S, float shift,
                  u16* __restrict__ Op, int ldo, float lam, float outmul, const float* ogain, float* __restrict__ o0s, char* smem) {
  constexpr int KSTR = DQK * 2 + 16, VSTR = DV * 2 + 16;
  constexpr int CK = DQK / 8, CV = DV / 8;
  constexpr int NKS = DQK / 16, NC = DV / 32;
  char* Kt = smem; char* Vt = smem + 14336;
  const int tid = otid(), lane = tid & 63, w = tid >> 6, r = lane & 31, h = lane >> 5;
  const int qtok = q0 + w * 32 + r;
  const int nt = S >> 6;
  const int kc0 = tid, kc1 = tid + 512;
  const int kr0 = kc0 / CK, kh0 = kc0 % CK, kr1 = kc1 / CK, kh1 = kc1 % CK;
  const bool k1ok = kc1 < 64 * CK;
  const int vr0 = kc0 / CV, vh0 = kc0 % CV, vr1 = kc1 / CV, vh1 = kc1 % CV;
  const bool v1ok = kc1 < 64 * CV;
  const int tq = (lane & 15) >> 2, tp = lane & 3, tblk = (lane >> 4) & 1;
#pragma unroll
  for (int m = 0; m < NM; ++m) {
    bf16x8 qf[NKS];
#pragma unroll
    for (int ks = 0; ks < NKS; ++ks) qf[ks] = *(const bf16x8*)(Qp + (size_t)qtok * ldq + m * qms + ks * 16 + 8 * h);
    f32x16 o[NC];
#pragma unroll
    for (int c = 0; c < NC; ++c)
#pragma unroll
      for (int i = 0; i < 16; ++i) o[c][i] = 0.f;
    float lsum = 0.f;
    const u16* Kb = Kp + m * kms;
    uint4 kreg0, kreg1 = make_uint4(0,0,0,0), vreg0, vreg1 = make_uint4(0,0,0,0);
    kreg0 = *(const uint4*)(Kb + (size_t)(kv0 + kr0) * ldk + kh0 * 8);
    if (k1ok) kreg1 = *(const uint4*)(Kb + (size_t)(kv0 + kr1) * ldk + kh1 * 8);
    vreg0 = *(const uint4*)(Vp + (size_t)(kv0 + vr0) * ldv + vh0 * 8);
    if (v1ok) vreg1 = *(const uint4*)(Vp + (size_t)(kv0 + vr1) * ldv + vh1 * 8);
    *(uint4*)(Kt + kr0 * KSTR + kh0 * 16) = kreg0;
    if (k1ok) *(uint4*)(Kt + kr1 * KSTR + kh1 * 16) = kreg1;
    *(uint4*)(Vt + vr0 * VSTR + vh0 * 16) = vreg0;
    if (v1ok) *(uint4*)(Vt + vr1 * VSTR + vh1 * 16) = vreg1;
    __syncthreads();
    for (int kt = 0; kt < nt; ++kt) {
      unsigned kofs = (unsigned)(r * KSTR + 16 * h) + (unsigned)(kt & 1) * 32768u;
      unsigned vofs = (unsigned)((4 * h + tq) * VSTR + (16 * tblk + 4 * tp) * 2) + 14336u + (unsigned)(kt & 1) * 32768u;
      asm volatile("" : "+v"(kofs), "+v"(vofs));
      const char* Kc = smem + kofs; const char* Vc = smem + vofs;
      if (kt + 1 < nt) {
        const int kb = kv0 + (kt + 1) * 64;
        kreg0 = *(const uint4*)(Kb + (size_t)(kb + kr0) * ldk + kh0 * 8);
        if (k1ok) kreg1 = *(const uint4*)(Kb + (size_t)(kb + kr1) * ldk + kh1 * 8);
        vreg0 = *(const uint4*)(Vp + (size_t)(kb + vr0) * ldv + vh0 * 8);
        if (v1ok) vreg1 = *(const uint4*)(Vp + (size_t)(kb + vr1) * ldv + vh1 * 8);
      }
      bf16x8 pf[2][2];
#pragma unroll
      for (int kb = 0; kb < 2; ++kb) {
        f32x16 s;
#pragma unroll
        for (int i = 0; i < 16; ++i) s[i] = -shift;
#pragma unroll
        for (int ks = 0; ks < NKS; ++ks) {
          const bf16x8 a = *(const bf16x8*)(Kc + kb * 32 * KSTR + ks * 32);
          s = __builtin_amdgcn_mfma_f32_32x32x16_bf16(a, qf[ks], s, 0, 0, 0);
        }
        float pv[16];
#pragma unroll
        for (int i = 0; i < 16; ++i) { pv[i] = __builtin_amdgcn_exp2f(s[i]); lsum += pv[i]; }
#pragma unroll
        for (int s2 = 0; s2 < 2; ++s2) {
          uint4 pk; pk.x = pk2(pv[8*s2+0], pv[8*s2+1]); pk.y = pk2(pv[8*s2+2], pv[8*s2+3]); pk.z = pk2(pv[8*s2+4], pv[8*s2+5]); pk.w = pk2(pv[8*s2+6], pv[8*s2+7]);
          pf[kb][s2] = __builtin_bit_cast(bf16x8, pk);
        }
      }
#pragma unroll
      for (int c = 0; c < NC; ++c)
#pragma unroll
        for (int kb = 0; kb < 2; ++kb)
#pragma unroll
          for (int s2 = 0; s2 < 2; ++s2) {
            const char* a0 = Vc + (kb * 32 + 16 * s2) * VSTR + 64 * c;
            const s16x4 lo = tr_read(a0);
            const s16x4 hi = tr_read(a0 + 8 * VSTR);
            const bf16x8 a = __builtin_shufflevector(lo, hi, 0, 1, 2, 3, 4, 5, 6, 7);
            o[c] = __builtin_amdgcn_mfma_f32_32x32x16_bf16(a, pf[kb][s2], o[c], 0, 0, 0);
            if (s2 == 1) __builtin_amdgcn_sched_barrier(0);
          }
      if (kt + 1 < nt) {
        char* Kn = Kt + ((kt + 1) & 1) * 32768; char* Vn = Vt + ((kt + 1) & 1) * 32768;
        *(uint4*)(Kn + kr0 * KSTR + kh0 * 16) = kreg0;
        if (k1ok) *(uint4*)(Kn + kr1 * KSTR + kh1 * 16) = kreg1;
        *(uint4*)(Vn + vr0 * VSTR + vh0 * 16) = vreg0;
        if (v1ok) *(uint4*)(Vn + vr1 * VSTR + vh1 * 16) = vreg1;
      }
      __syncthreads();
    }
    const float ltot = lsum + shx<32>(lsum);
    const float inv = 1.f / ltot;
    if (NM == 2 && m == 0) {
#pragma unroll
      for (int c = 0; c < NC; ++c)
#pragma unroll
        for (int g = 0; g < 4; ++g)
          *(float4*)(o0s + (size_t)qtok * 512 + 32 * c + 8 * g + 4 * h) = make_float4(o[c][4*g] * inv, o[c][4*g+1] * inv, o[c][4*g+2] * inv, o[c][4*g+3] * inv);
    } else {
      if (NM == 2) {
        float ss = 0.f;
#pragma unroll
        for (int c = 0; c < NC; ++c)
#pragma unroll
          for (int g = 0; g < 4; ++g) {
            const float4 p0 = *(const float4*)(o0s + (size_t)qtok * 512 + 32 * c + 8 * g + 4 * h);
            const float v0 = p0.x - lam * o[c][4*g] * inv, v1 = p0.y - lam * o[c][4*g+1] * inv, v2 = p0.z - lam * o[c][4*g+2] * inv, v3 = p0.w - lam * o[c][4*g+3] * inv;
            o[c][4*g] = v0; o[c][4*g+1] = v1; o[c][4*g+2] = v2; o[c][4*g+3] = v3;
            ss += v0 * v0 + v1 * v1 + v2 * v2 + v3 * v3;
          }
        ss += shx<32>(ss);
        const float rr = rsqrtf(ss * (1.f / (float)DV) + EPS) * outmul;
#pragma unroll
        for (int c = 0; c < NC; ++c)
#pragma unroll
          for (int g = 0; g < 4; ++g) {
            const int dvb = 32 * c + 8 * g + 4 * h;
            const float4 gg = *(const float4*)(ogain + dvb);
            uint2 st; st.x = pk2(o[c][4*g] * rr * gg.x, o[c][4*g+1] * rr * gg.y); st.y = pk2(o[c][4*g+2] * rr * gg.z, o[c][4*g+3] * rr * gg.w);
            *(uint2*)(Op + (size_t)qtok * ldo + dvb) = st;
          }
      } else {
#pragma unroll
        for (int c = 0; c < NC; ++c)
#pragma unroll
          for (int g = 0; g < 4; ++g) {
            const int dvb = 32 * c + 8 * g + 4 * h;
            uint2 st; st.x = pk2(o[c][4*g] * inv, o[c][4*g+1] * inv); st.y = pk2(o[c][4*g+2] * inv, o[c][4*g+3] * inv);
            *(uint2*)(Op + (size_t)qtok * ldo + dvb) = st;
          }
      }
    }
  }
}

DI float max_abs(const float* g, int n) { float m = 0.f; for (int i = 0; i < n; ++i) m = fmaxf(m, fabsf(g[i])); return m; }

DI void phase_attn(const Params& p, int l, char* smem) {
  char* ws = ows(p.ws);
  const u16* proj = (const u16*)(ws + WS_PROJ);
  const u16* dk = (const u16*)(ws + WS_DK); const u16* dv = (const u16*)(ws + WS_DV);
  const u16* mk = (const u16*)(ws + WS_MK); const u16* mv = (const u16*)(ws + WS_MV);
  const u16* gk = (const u16*)(ws + WS_GK); const u16* gv = (const u16*)(ws + WS_GV);
  u16* ob = (u16*)(ws + WS_OB);
  unsigned* ctr = (unsigned*)(ws + WS_CTR) + l;
  int* sitem = (int*)(smem + 65536);
  const float shA = uni(8.f * max_abs(p.in[14] + l * 128, 64) * max_abs(p.in[14] + l * 128 + 64, 64) * LOG2E);
  const float shB = uni(9.797958971132712f * max_abs(p.in[21] + l * 192, 96) * max_abs(p.in[21] + l * 192 + 96, 96) * LOG2E);
  const float shC = uni(8.f * max_abs(p.in[22] + l * 128, 64) * max_abs(p.in[22] + l * 128 + 64, 64) * LOG2E);
  const float lam_init = 0.8f - 0.6f * expf(-0.3f * (float)l);
  float d1 = 0.f, d2 = 0.f;
  { const float* lv = p.in[15] + l * 256; for (int i = 0; i < 64; ++i) { d1 += lv[i] * lv[64 + i]; d2 += lv[128 + i] * lv[192 + i]; } }
  const float lam = uni(expf(d1) - expf(d2) + lam_init);
  const float omul = uni(1.f - lam_init);
  const float* ogain = p.in[16] + l * 128;
  if (otid() == 0) sitem[0] = (int)atomicAdd(ctr, 1u);
  for (int par = 0;; par ^= 1) {
    __syncthreads();
    const int it = sitem[par];
    if (it >= 1280) break;
    if (otid() == 0) sitem[par ^ 1] = (int)atomicAdd(ctr, 1u);
    int cls, idx;
    if (it < 128) { cls = 0; idx = it; } else if (it < 384) { cls = 1; idx = it - 128; } else if (it < 640) { cls = 2; idx = it - 384; }
    else if (it < 768) { cls = 3; idx = it - 640; } else if (it < 1024) { cls = 4; idx = it - 768; } else { cls = 5; idx = it - 1024; }
    const bool lat = cls < 3; const int typ = lat ? cls : cls - 3;
    const int nh = typ == 0 ? 4 : 8;
    const int head = idx % nh; const int sq = idx / nh;
    int q0, kv0, S;
    if (lat) { const int s = sq >> 3, qt = sq & 7; q0 = NCTX + s * DEC_SEQ + qt * 256; kv0 = NCTX + s * SLAT; S = SLAT; }
    else { q0 = sq * 256; kv0 = sq * 256; S = 256; }
    if (typ == 0) {
      attn_item<64, 128, 2>(proj + C_AQ + head * 64, PLD, 256, dk + head * 64, 512, 256, dv + head * 128, 512, q0, kv0, S, shA,
                            ob + head * 128, 1536, lam, omul, ogain, (float*)(ws + WS_O0) + head * 128, smem);
    } else if (typ == 1) {
      attn_item<96, 64, 1>(proj + C_MLAQ + head * 96, PLD, 0, mk + head * 96, 768, 0, mv + head * 64, 512, q0, kv0, S, shB,
                           ob + 512 + head * 64, 1536, 0.f, 1.f, ogain, nullptr, smem);
    } else {
      attn_item<64, 64, 1>(proj + C_CQ + head * 64, PLD, 0, gk + (head >> 2) * 64, 128, 0, gv + (head >> 2) * 64, 128, q0, kv0, S, shC,
                           ob + 1024 + head * 64, 1536, 0.f, 1.f, ogain, nullptr, smem);
    }
  }
}

DI void phase_conv(const Params& p, int l) {
  char* ws = ows(p.ws);
  const u16* u = (const u16*)(ws + WS_PROJ);
  u16* act = (u16*)(ws + WS_ACT);
  const float* cw = p.in[29] + (size_t)l * 3 * UP; const float* cb = p.in[30] + (size_t)l * UP;
  const int gtid = obid() * 512 + otid(), nth = ogrid() * 512;
  constexpr int STRIP = 32, NSTRIP = NTOK / STRIP;
  for (int i = gtid; i < NSTRIP * 352; i += nth) {
    const int strip = i / 352, j = (i % 352) * 8;
    const int t0 = strip * STRIP;
    int pos0, len;
    if (t0 < NCTX) { pos0 = t0 & 255; len = 256; } else { pos0 = (t0 - NCTX) & 2047; len = 2048; }
    float wa0[8], wa1[8], wa2[8], ba[8], wg0[8], wg1[8], wg2[8], bg[8];
    ld8f(cw + j, wa0); ld8f(cw + UP + j, wa1); ld8f(cw + 2 * UP + j, wa2); ld8f(cb + j, ba);
    ld8f(cw + DFF + j, wg0); ld8f(cw + UP + DFF + j, wg1); ld8f(cw + 2 * UP + DFF + j, wg2); ld8f(cb + DFF + j, bg);
    const u16* ua = u + (size_t)t0 * UP + j;
    const uint4 z4 = make_uint4(0, 0, 0, 0);
    uint4 am = pos0 > 0 ? *(const uint4*)(ua - UP) : z4, gm = pos0 > 0 ? *(const uint4*)(ua - UP + DFF) : z4;
    uint4 a0 = *(const uint4*)ua, g0 = *(const uint4*)(ua + DFF);
#pragma unroll 4
    for (int k = 0; k < STRIP; ++k) {
      const bool hn = pos0 + k < len - 1;
      const uint4 ap = hn ? *(const uint4*)(ua + (size_t)(k + 1) * UP) : z4;
      const uint4 gp = hn ? *(const uint4*)(ua + (size_t)(k + 1) * UP + DFF) : z4;
      float xm[8], x0[8], xp[8], ym[8], y0[8], yp[8], o[8];
      unpack8(am, xm); unpack8(a0, x0); unpack8(ap, xp); unpack8(gm, ym); unpack8(g0, y0); unpack8(gp, yp);
#pragma unroll
      for (int q = 0; q < 8; ++q) {
        const float av = xm[q] * wa0[q] + x0[q] * wa1[q] + xp[q] * wa2[q] + ba[q];
        const float gv = ym[q] * wg0[q] + y0[q] * wg1[q] + yp[q] * wg2[q] + bg[q];
        o[q] = av * siluf(gv);
      }
      *(uint4*)(act + (size_t)(t0 + k) * DFF + j) = pack8(o);
      am = a0; a0 = ap; gm = g0; g0 = gp;
    }
  }
}

__global__ void __launch_bounds__(512) mega(Params p) {
  extern __shared__ __attribute__((aligned(16))) char smem[];
  cg::grid_group grid = cg::this_grid();
  char* ws = ows(p.ws);

  __shared__ uint4 xb_words;
  otid_init();
  if (otid() == 0) xb_words = make_uint4(0u, 0u, 0u, 0u);
  __syncthreads();
  XcdBarrier xb = xcd_barrier_post((unsigned*)(ws + WS_BAR), (volatile LAS unsigned*)&xb_words);
  phase0(p, smem);
  convert_layer(p, 0, smem);
  grid.sync();
  if (otid() == 0) {
    unsigned* bar = (unsigned*)(ws + WS_BAR);
    const unsigned nxc = gridDim.x >> 5; bool ok = (nxc * 32u == gridDim.x) && nxc <= 16u;
    for (unsigned j = 0; j < 16; ++j) { const unsigned c = xb_ld(&bar[XB_XCNT(j)]); ok = ok && (c == (j < nxc ? 32u : 0u)); }
    { unsigned nloc, nx; xcd_barrier_complete(bar, xb.x, nloc, nx); ((volatile LAS unsigned*)&xb_words)[0] = nloc; ((volatile LAS unsigned*)&xb_words)[1] = nx; }
    const unsigned rank = ((volatile LAS unsigned*)&xb_words)[2];
    ((volatile LAS unsigned*)&xb_words)[3] = ok ? xb.x * 32u + rank : blockIdx.x;
  }
  __syncthreads();
  phase0b(p);
#pragma unroll 1
  for (int l = 0; l < DEPTH; ++l) {
    const int vb = __builtin_amdgcn_readfirstlane(((volatile LAS unsigned*)&xb_words)[3]);
    char* ws = ows(p.ws);
    u16* hbuf = (u16*)(ws + WS_H);
    u16* proj = (u16*)(ws + WS_PROJ);
    const float* mod = (const float*)(ws + WS_MOD);
    const float* cosR = (const float*)(ws + WS_ROPE) + 131072; const float* sinR = cosR + 32768;
    if (l > 0) convert_layer(p, l, smem);
    xcd_barrier(xb);
    const float* modl = mod + (size_t)l * 5 * 6144;
    const float* xs0 = l == 0 ? p.in[0] : p.out; const float* xs1 = l == 0 ? p.in[1] : p.out + (size_t)NCTX * 1024;
    phase3_cached(p, l);
    { const float* cosH = (const float*)(ws + WS_ROPE);
      EpiProj2 e{proj, (u16*)(ws + WS_DK), (u16*)(ws + WS_DV), (u16*)(ws + WS_GK), (u16*)(ws + WS_GV), (u16*)(ws + WS_CKVN), (float*)(ws + WS_KPE),
                 (float*)(ws + WS_QDSS), p.out, p.in[14] + l * 128, p.in[17] + l * 256, p.in[19] + l * 128, p.in[22] + l * 128, cosH, cosH + 65536, l};
      PreNorm pn1{hbuf, p.in[12] + l * 1024, modl, 0, 1024, xs0, xs1, -1};
      gemm_phase(hbuf, 1024, (const u16*)(ws + WS_WIN), 1024, 1024, 64, 23, smem, e, 0, 64 * 23 + 16, vb, pn1);
      EpiKvup ekc{(u16*)(ws + WS_MK), (u16*)(ws + WS_MV), (const float*)(ws + WS_KPE), p.in[21] + l * 192 + 96, cosR, sinR};
      PreCkv pc{p.in[5], p.in[6], p.in[19] + l * 128, (u16*)(ws + WS_CKVN), (float*)(ws + WS_KPE), l};
      gemm_phase<EpiKvup, PreCkv, 2>((const u16*)(ws + WS_CKVN), 256, (const u16*)(ws + WS_WKV), 256, 256, 4, 4, smem, ekc, 64 * 23, 64 * 23 + 16, vb, pc); }
    xcd_barrier(xb);
    {
      EpiQup eq{proj, p.in[21] + l * 192, cosR, sinR, (const float*)(ws + WS_QDSS)};
      gemm_phase(proj + C_BQD, PLD, (const u16*)(ws + WS_WQU), 256, 256, 64, 4, smem, eq, 0, 512, vb);
      EpiKvup ek{(u16*)(ws + WS_MK), (u16*)(ws + WS_MV), (const float*)(ws + WS_KPE), p.in[21] + l * 192 + 96, cosR, sinR};
      gemm_phase<EpiKvup, NoPre, 1>((const u16*)(ws + WS_CKVN), 256, (const u16*)(ws + WS_WKV), 256, 256, 64, 4, smem, ek, 256, 512, vb);
    }
    xcd_barrier(xb);
    phase_attn(p, l, smem);
    xcd_barrier(xb);
    merge_phase((const u16*)(ws + WS_OB), (const u16*)(ws + WS_WB), proj, hbuf, smem, vb);
    xcd_barrier(xb);
    { EpiResid er{p.out, modl, 2048, xs0, xs1}; gemm_phase(hbuf, 1024, (const u16*)(ws + WS_WO), 1024, 1024, 64, 4, smem, er, 0, 256, vb); }
    xcd_barrier(xb);
    { EpiConv ec{(u16*)(ws + WS_ACT), (u16*)(ws + WS_HALO), p.in[29] + (size_t)l * 3 * UP, p.in[30] + (size_t)l * UP};
      PreNorm pn2{hbuf, p.in[27] + l * 1024, modl, 3072, 4096, p.out, p.out + (size_t)NCTX * 1024, -1};
      gemm_phase(hbuf, 1024, (const u16*)(ws + WS_WUP), 1024, 1024, 64, 22, smem, ec, 0, 64 * 22, vb, pn2); }
    xcd_barrier(xb);
    { EpiResid er{p.out, modl, 5120, p.out, p.out + (size_t)NCTX * 1024}; PreFix pf{(u16*)(ws + WS_ACT), (const u16*)(ws + WS_HALO), p.in[29] + (size_t)l * 3 * UP, p.in[30] + (size_t)l * UP};
      gemm_phase((const u16*)(ws + WS_ACT), DFF, (const u16*)(ws + WS_WD), DFF, DFF, 64, 4, smem, er, 0, 256, vb, pf); }
    if (l + 1 < DEPTH) xcd_barrier(xb);
  }
}

extern "C" void kernel_launch(void* const* d_in, const int* in_sizes, int n_in, void* d_out, int out_size, void* d_ws, size_t ws_size, hipStream_t stream) {
  static int grid_blocks = 0;
  if (grid_blocks == 0) {
    if (n_in != 32 || ws_size < WS_END) { fprintf(stderr, "kernel_launch: bad n_in %d or ws_size %zu < %zu\n", n_in, ws_size, (size_t)WS_END); grid_blocks = -1; return; }
    int dev = 0, cus = 0, per_cu = 0;
    hipGetDevice(&dev);
    hipDeviceGetAttribute(&cus, hipDeviceAttributeMultiprocessorCount, dev);
    hipFuncSetAttribute((const void*)mega, hipFuncAttributeMaxDynamicSharedMemorySize, LDS_BYTES);
    hipOccupancyMaxActiveBlocksPerMultiprocessor(&per_cu, (const void*)mega, 512, LDS_BYTES);
    if (per_cu < 1) per_cu = 1;
    grid_blocks = cus * per_cu;
  }
  if (grid_blocks < 0) return;
  (void)hipMemsetAsync((char*)d_ws + WS_CTR, 0, 256 + XCD_BAR_WORDS_C * 4, stream);
  Params p{};
  for (int i = 0; i < 32; ++i) p.in[i] = (const float*)d_in[i];
  p.out = (float*)d_out; p.ws = (char*)d_ws;
  void* args[] = {&p};
  hipError_t e = hipLaunchCooperativeKernel((const void*)mega, dim3(grid_blocks), dim3(512), args, LDS_BYTES, stream);
  if (e != hipSuccess) fprintf(stderr, "cooperative launch failed: %s (grid %d)\n", hipGetErrorString(e), grid_blocks);
}
```

```cpp
#include <hip/hip_runtime.h>
#include <hip/hip_bf16.h>
#include <hip/hip_cooperative_groups.h>
#include <cstdio>
namespace cg = cooperative_groups;

typedef unsigned short u16;
using bf16x8 = __attribute__((ext_vector_type(8))) short;
using s16x4  = __attribute__((ext_vector_type(4))) short;
using f32x4  = __attribute__((ext_vector_type(4))) float;
using f32x16 = __attribute__((ext_vector_type(16))) float;
#define DI __device__ __forceinline__

constexpr int D = 1024, NTOK = 16384, NCTX = 8192, DEPTH = 4;
constexpr int SEQ = 256, DEC_SEQ = 2048, PAST = 256, SLAT = PAST + DEC_SEQ;
constexpr int KVROWS = NCTX + 4 * SLAT;
constexpr int IN_COLS = 5792, PLD = 5888;
constexpr int C_AQ = 0, C_AK = 512, C_AV = 1024, C_BQD = 1536, C_CQ = 1792, C_CK = 2304, C_CV = 2432, C_CKV = 2560, C_KPE = 2688, C_GATE = 2816;
constexpr int C_MLAQ = 512;
constexpr int DFF = 2816, UP = 5632;
constexpr float EPS = 1e-6f;
constexpr float LOG2E = 1.4426950408889634f;

constexpr int XCD_BAR_WORDS_C = 3456;
constexpr size_t al256(size_t x) { return (x + 255) & ~(size_t)255; }
constexpr size_t WS_WIN  = 0;
constexpr size_t WS_WQU  = WS_WIN + al256((size_t)PLD * 1024 * 2);
constexpr size_t WS_WKV  = WS_WQU + al256((size_t)1024 * 256 * 2);
constexpr size_t WS_WB   = WS_WKV + al256((size_t)1024 * 256 * 2);
constexpr size_t WS_WO   = WS_WB + al256((size_t)3 * 1024 * 512 * 2);
constexpr size_t WS_WUP  = WS_WO + al256((size_t)1024 * 1024 * 2);
constexpr size_t WS_WD   = WS_WUP + al256((size_t)UP * 1024 * 2);
constexpr size_t WS_H    = WS_WD + al256((size_t)1024 * DFF * 2);
constexpr size_t WS_PROJ = WS_H + al256((size_t)NTOK * 1024 * 2);
constexpr size_t WS_KV   = WS_PROJ + al256((size_t)NTOK * PLD * 2);
constexpr size_t WS_DK   = WS_KV;
constexpr size_t WS_DV   = WS_DK + al256((size_t)KVROWS * 512 * 2);
constexpr size_t WS_MK   = WS_DV + al256((size_t)KVROWS * 512 * 2);
constexpr size_t WS_MV   = WS_MK + al256((size_t)KVROWS * 768 * 2);
constexpr size_t WS_GK   = WS_MV + al256((size_t)KVROWS * 512 * 2);
constexpr size_t WS_GV   = WS_GK + al256((size_t)KVROWS * 128 * 2);
constexpr size_t WS_CKVN = WS_GV + al256((size_t)KVROWS * 128 * 2);
constexpr size_t WS_KPE  = WS_CKVN + al256((size_t)KVROWS * 256 * 2);
constexpr size_t WS_OB   = WS_KPE + al256((size_t)KVROWS * 32 * 4);
constexpr size_t WS_MOD  = WS_OB + al256((size_t)NTOK * 1536 * 2);
constexpr size_t WS_MODP = WS_MOD + al256((size_t)4 * 5 * 6144 * 4);
constexpr size_t WS_ROPE = WS_MODP + al256((size_t)16 * 4 * 5 * 6144 * 4);
constexpr size_t WS_CTR  = WS_ROPE + al256((size_t)2048 * 96 * 4);
constexpr size_t WS_BAR  = WS_CTR + 256;
constexpr size_t WS_O0   = WS_BAR + al256((size_t)XCD_BAR_WORDS_C * 4);
constexpr size_t WS_HALO = WS_O0 + al256((size_t)NTOK * 512 * 4);
constexpr size_t WS_QDSS = WS_HALO + al256((size_t)32 * 22 * 4 * 256 * 2);
constexpr size_t WS_END  = WS_QDSS + al256((size_t)NTOK * 2 * 4);
constexpr size_t WS_M32  = WS_KV;
constexpr size_t WS_ACT  = WS_KV;
static_assert(WS_OB + (size_t)NTOK * 1536 * 2 - WS_KV >= (size_t)NTOK * DFF * 2, "act alias");
static_assert(WS_OB - WS_KV >= (size_t)NTOK * 1024 * 4, "m32 alias");

constexpr int LDS_BYTES = 136192;

struct Params {
  const float* in[32];
  float* out;
  char* ws;
};

constexpr size_t O_X = 0, O_NDK = 16777216, O_NDV = 33554432, O_NCKV = 50331648, O_NKPE = 54525952, O_NGK = 55574528, O_NGV = 59768832;

DI u16 f2bf(float x) { unsigned u = __float_as_uint(x); u += 0x7fffu + ((u >> 16) & 1u); return (u16)(u >> 16); }
DI float bf2f(u16 v) { return __uint_as_float(((unsigned)v) << 16); }
typedef __bf16 bf16x2_t __attribute__((ext_vector_type(2)));
typedef float f32x2_t __attribute__((ext_vector_type(2)));
DI unsigned pk2(float a, float b) { f32x2_t f; f[0] = a; f[1] = b; return __builtin_bit_cast(unsigned, __builtin_convertvector(f, bf16x2_t)); }
DI void unpack8(uint4 r, float* x) {
  x[0] = __uint_as_float(r.x << 16); x[1] = __uint_as_float(r.x & 0xffff0000u);
  x[2] = __uint_as_float(r.y << 16); x[3] = __uint_as_float(r.y & 0xffff0000u);
  x[4] = __uint_as_float(r.z << 16); x[5] = __uint_as_float(r.z & 0xffff0000u);
  x[6] = __uint_as_float(r.w << 16); x[7] = __uint_as_float(r.w & 0xffff0000u);
}
DI uint4 pack8(const float* x) { uint4 r; r.x = pk2(x[0], x[1]); r.y = pk2(x[2], x[3]); r.z = pk2(x[4], x[5]); r.w = pk2(x[6], x[7]); return r; }
DI void ld8f(const float* p, float* x) { float4 a = *(const float4*)p, b = *(const float4*)(p + 4); x[0]=a.x;x[1]=a.y;x[2]=a.z;x[3]=a.w;x[4]=b.x;x[5]=b.y;x[6]=b.z;x[7]=b.w; }
DI void st8f(float* p, const float* x) { *(float4*)p = make_float4(x[0],x[1],x[2],x[3]); *(float4*)(p + 4) = make_float4(x[4],x[5],x[6],x[7]); }
template <int M> DI float shx(float v) {
  if constexpr (M < 32) return __int_as_float(__builtin_amdgcn_ds_swizzle(__float_as_int(v), (M << 10) | 0x1f));
  else {
    unsigned z = 0u; asm volatile("" : "+v"(z));
    const unsigned lane = __builtin_amdgcn_mbcnt_hi(~0u, __builtin_amdgcn_mbcnt_lo(~0u, z));
    return __int_as_float(__builtin_amdgcn_ds_bpermute((int)((lane ^ 32u) << 2), __float_as_int(v)));
  }
}
DI float wave_sum(float v) { v += shx<32>(v); v += shx<16>(v); v += shx<8>(v); v += shx<4>(v); v += shx<2>(v); v += shx<1>(v); return v; }
DI float siluf(float x) { return x * __builtin_amdgcn_rcpf(1.f + __expf(-x)); }
DI float sigmoidf(float x) { return __builtin_amdgcn_rcpf(1.f + __expf(-x)); }
__shared__ unsigned g_wslot[64];
DI unsigned hw_slot() { return (unsigned)__builtin_amdgcn_s_getreg((6 << 11) | 4) & 63u; }
DI void otid_init() {
  const unsigned t = threadIdx.x;
  if ((t & 63u) == 0u) g_wslot[hw_slot()] = t >> 6;
  __syncthreads();
}
DI int otid() {
  const unsigned w = (unsigned)__builtin_amdgcn_readfirstlane((int)((volatile __attribute__((address_space(3))) unsigned*)g_wslot)[hw_slot()]);
  unsigned z = 0u; asm volatile("" : "+v"(z));
  int t = (int)(w * 64u + __builtin_amdgcn_mbcnt_hi(~0u, __builtin_amdgcn_mbcnt_lo(~0u, z)));
  asm volatile("" : "+v"(t));
  return t;
}
DI int obid() { int b = blockIdx.x; asm volatile("" : "+s"(b)); return b; }
DI int ogrid() { int g = gridDim.x; asm volatile("" : "+s"(g)); return g; }
DI char* ows(char* w) { size_t z = 0; asm volatile("" : "+s"(z)); return w + z; }
DI float uni(float x) { return __int_as_float(__builtin_amdgcn_readfirstlane(__float_as_int(x))); }
DI int tok_group(int t) { return t < NCTX ? 0 : 1 + ((t - NCTX) >> 11); }


#define XB_TMO      128
#define XB_XCNT(j)  (256  + 64 * (j))
#define XB_XSUB(j)  (1280 + 64 * (j))
#define XB_XGEN(j)  (2304 + 64 * (j))
#define XB_TOP      3328
#define XB_TOPGEN   3392
#define XCD_BAR_WORDS 3456
#define XB_SPIN_CAP (1u << 18)
#define LAS __attribute__((address_space(3)))
DI unsigned xb_ld(unsigned* p)              { return __hip_atomic_load(p, __ATOMIC_RELAXED, __HIP_MEMORY_SCOPE_AGENT); }
DI unsigned xb_add(unsigned* p, unsigned v) { return __hip_atomic_fetch_add(p, v, __ATOMIC_RELAXED, __HIP_MEMORY_SCOPE_AGENT); }
DI unsigned xb_xcc_id() { return (unsigned)__builtin_amdgcn_s_getreg((3 << 11) | 20) & 0xFu; }
#define XB_SPIN(cond, bar) do { unsigned _sp = 0; while (cond) { __builtin_amdgcn_s_sleep(1); \
    if ((++_sp & 255u) == 0u) { if (xb_ld(&(bar)[XB_TMO])) break; if (_sp > XB_SPIN_CAP) { atomicAdd(&(bar)[XB_TMO], 1u); break; } } } } while (0)
struct XcdBarrier { unsigned* bar; unsigned x; volatile LAS unsigned* st; };
DI XcdBarrier xcd_barrier_post(unsigned* bar, volatile LAS unsigned* st) {
  XcdBarrier b; b.bar = bar; b.x = xb_xcc_id(); b.st = st;
  if (otid() == 0) st[2] = xb_add(&bar[XB_XCNT(b.x)], 1u);
  return b;
}
DI void xcd_barrier_complete(unsigned* bar, unsigned x, unsigned& nloc, unsigned& nx) {
  const unsigned G = gridDim.x;
  unsigned sum, cnt, mine, sp = 0u;
  for (;;) {
    sum = 0u; cnt = 0u; mine = 0u;
#pragma unroll
    for (unsigned j = 0; j < 16; ++j) { const unsigned c = xb_ld(&bar[XB_XCNT(j)]); sum += c; cnt += (c > 0u) ? 1u : 0u; mine = (j == x) ? c : mine; }
    if (sum == G) break;
    __builtin_amdgcn_s_sleep(1);
    if ((++sp & 255u) == 0u) { if (xb_ld(&bar[XB_TMO])) break; if (sp > XB_SPIN_CAP) { atomicAdd(&bar[XB_TMO], 1u); break; } }
  }
  nloc = mine > 0u ? mine : 1u; nx = cnt > 0u ? cnt : 1u;
}
DI void xcd_barrier(const XcdBarrier& b) {
  asm volatile("s_waitcnt vmcnt(0)" ::: "memory");
  __syncthreads();
  if (otid() == 0) {
    unsigned* bar = b.bar; unsigned bx = b.x;
    asm volatile("" : "+s"(bar), "+s"(bx));
    __builtin_amdgcn_s_waitcnt(0);
    unsigned nloc = b.st[0], nx = b.st[1];
    const unsigned old = xb_add(&bar[XB_XSUB(bx)], 1u);
    const unsigned gen = old / nloc;
    if (old + 1u == (gen + 1u) * nloc) {
      __builtin_amdgcn_fence(__ATOMIC_RELEASE, "agent");
      asm volatile("s_waitcnt vmcnt(0)" ::: "memory");
      const unsigned og = xb_add(&bar[XB_TOP], 1u);
      const unsigned tg = og / nx;
      if (og + 1u == (tg + 1u) * nx) xb_add(&bar[XB_TOPGEN], 1u);
      else XB_SPIN(xb_ld(&bar[XB_TOPGEN]) == tg, bar);
      __builtin_amdgcn_fence(__ATOMIC_ACQUIRE, "agent");
      xb_add(&bar[XB_XGEN(bx)], 1u);
      asm volatile("s_waitcnt vmcnt(0)" ::: "memory");
    } else {
      XB_SPIN(xb_ld(&bar[XB_XGEN(bx)]) == gen, bar);
      __builtin_amdgcn_fence(__ATOMIC_ACQUIRE, "agent");
      asm volatile("s_waitcnt vmcnt(0)" ::: "memory");
    }
  }
  __syncthreads();
}

constexpr int BM = 256, BK = 64, HALF = 128, HT = HALF * BK;
DI int lds_byte(int r, int c) {
  int st = (r >> 4) * 2 + (c >> 5), rr = r & 15, cc = c & 31, ob = rr * 64 + cc * 2;
  return st * 1024 + (ob ^ (((ob >> 9) & 1) << 5));
}
DI void stage_rc(int b, int& R, int& C) {
  int st = b / 1024, sb = b % 1024, swz = sb ^ (((sb >> 9) & 1) << 5);
  R = (st >> 1) * 16 + swz / 64; C = (st & 1) * 32 + (swz % 64) / 2;
}
constexpr int EPLD = 132;

template <bool ZERO>
DI void gemm_kloop(const u16* __restrict__ A, int lda, const u16* __restrict__ Bt, int ldb, int K, int brow, int bcol, char* smem, f32x4 (&acc)[2][2][4][2], int tid) {
  u16* shm = (u16*)smem;
  brow = __builtin_amdgcn_readfirstlane(brow); bcol = __builtin_amdgcn_readfirstlane(bcol);
#define SA(b,h) (shm+((b)*2+(h))*HT)
#define SB(b,h) (shm+(4+(b)*2+(h))*HT)
#define STAGE_(P,BASE,LD,br,kt,O0,O1) do{ const char* _gb=(const char*)((BASE)+((long)(br)*(LD)+(long)(kt)*BK)); asm volatile("" : "+s"(_gb)); \
    unsigned _o0=(O0), _o1=(O1); asm volatile("" : "+v"(_o0), "+v"(_o1)); \
    __builtin_amdgcn_global_load_lds((const unsigned*)(_gb+(size_t)_o0), (unsigned*)((char*)(P)+wv1024),16,0,0); \
    __builtin_amdgcn_global_load_lds((const unsigned*)(_gb+(size_t)_o1), (unsigned*)((char*)(P)+wv1024+8192),16,0,0); \
    }while(0)
#define STAGE(P,BASE,LD,br,kt) STAGE_##BASE(P,BASE,LD,br,kt)
#define STAGE_A(P,BASE,LD,br,kt) STAGE_(P,BASE,LD,br,kt,aoff0,aoff1)
#define STAGE_Bt(P,BASE,LD,br,kt) STAGE_(P,BASE,LD,br,kt,boff0,boff1)
#define LDA(dst,b,h) for(int m=0;m<4;++m)for(int k=0;k<2;++k) \
    dst[m][k]=*reinterpret_cast<const bf16x8*>((char*)SA(b,h)+lds_byte(wr*64+m*16+fr,k*32+fq*8))
#define LDB(dst,b,h) for(int n=0;n<2;++n)for(int k=0;k<2;++k) \
    dst[n][k]=*reinterpret_cast<const bf16x8*>((char*)SB(b,h)+lds_byte(wc*32+n*16+fr,k*32+fq*8))
#define MMA(ai,bj,At,Bx) do{__builtin_amdgcn_s_setprio(1); \
    for(int m=0;m<4;++m)for(int n=0;n<2;++n)for(int k=0;k<2;++k) \
      acc[ai][bj][m][n]=__builtin_amdgcn_mfma_f32_16x16x32_bf16(At[m][k],Bx[n][k],acc[ai][bj][m][n],0,0,0); \
    __builtin_amdgcn_s_setprio(0);}while(0)
#define WAIT_V(n) asm volatile("s_waitcnt vmcnt(" #n ")":::"memory")
#define WAIT_L(n) asm volatile("s_waitcnt lgkmcnt(" #n ")":::"memory")
#define BAR __builtin_amdgcn_s_barrier()
#define SCHED __builtin_amdgcn_sched_barrier(0)
  const int wid = tid >> 6, lane = tid & 63, wr = wid >> 2, wc = wid & 3, fr = lane & 15, fq = lane >> 4;
  if (ZERO) {
#pragma unroll
    for (int a = 0; a < 2; ++a)
#pragma unroll
      for (int b = 0; b < 2; ++b)
#pragma unroll
        for (int m = 0; m < 4; ++m)
#pragma unroll
          for (int n = 0; n < 2; ++n) acc[a][b][m][n] = f32x4{0.f, 0.f, 0.f, 0.f};
  }
  bf16x8 At[4][2], B0[2][2], B1[2][2];
  const int nt = K / BK;
  const int wv1024 = __builtin_amdgcn_readfirstlane(tid >> 6) * 1024;
  unsigned aoff0, aoff1, boff0, boff1;
  { int _r, _c; stage_rc(tid * 16, _r, _c); aoff0 = (unsigned)(_r * lda + _c) * 2u; boff0 = (unsigned)(_r * ldb + _c) * 2u;
    stage_rc(tid * 16 + 8192, _r, _c); aoff1 = (unsigned)(_r * lda + _c) * 2u; boff1 = (unsigned)(_r * ldb + _c) * 2u; }
  asm volatile("s_waitcnt vmcnt(0) lgkmcnt(0)" ::: "memory");
  __syncthreads();
  STAGE(SB(0,0),Bt,ldb,bcol,0); STAGE(SA(0,0),A,lda,brow,0);
  STAGE(SB(0,1),Bt,ldb,bcol+HALF,0); STAGE(SA(0,1),A,lda,brow+HALF,0);
  if (wr == 1) BAR;
  WAIT_V(4); BAR;
  STAGE(SB(1,0),Bt,ldb,bcol,1); STAGE(SA(1,0),A,lda,brow,1); STAGE(SB(1,1),Bt,ldb,bcol+HALF,1);
  WAIT_V(6); BAR;
  for (int t = 0; t < nt - 2; t += 2) {
    LDB(B0,0,0); SCHED; LDA(At,0,0); STAGE(SA(1,1),A,lda,brow+HALF,t+1);
    WAIT_L(8); BAR; WAIT_L(0); MMA(0,0,At,B0); BAR; SCHED;
    LDB(B1,0,1); STAGE(SB(0,0),Bt,ldb,bcol,t+2);
    BAR; WAIT_L(0); MMA(0,1,At,B1); BAR;
    LDA(At,0,1); STAGE(SA(0,0),A,lda,brow,t+2);
    BAR; WAIT_L(0); MMA(1,0,At,B0); BAR; SCHED;
    STAGE(SB(0,1),Bt,ldb,bcol+HALF,t+2);
    WAIT_V(6); BAR; MMA(1,1,At,B1); BAR;
    LDB(B0,1,0); SCHED; LDA(At,1,0); STAGE(SA(0,1),A,lda,brow+HALF,t+2);
    WAIT_L(8); BAR; WAIT_L(0); MMA(0,0,At,B0); BAR; SCHED;
    LDB(B1,1,1); STAGE(SB(1,0),Bt,ldb,bcol,t+3);
    BAR; WAIT_L(0); MMA(0,1,At,B1); BAR;
    LDA(At,1,1); STAGE(SA(1,0),A,lda,brow,t+3);
    BAR; WAIT_L(0); MMA(1,0,At,B0); BAR; SCHED;
    STAGE(SB(1,1),Bt,ldb,bcol+HALF,t+3);
    WAIT_V(6); BAR; MMA(1,1,At,B1); BAR;
  }
  { LDB(B0,0,0); LDA(At,0,0); STAGE(SA(1,1),A,lda,brow+HALF,nt-1);
    BAR; WAIT_L(0); MMA(0,0,At,B0); BAR;
    LDB(B1,0,1); BAR; WAIT_L(0); MMA(0,1,At,B1); BAR;
    LDA(At,0,1); WAIT_V(4); BAR; WAIT_L(0); MMA(1,0,At,B0); MMA(1,1,At,B1); BAR; }
  { LDB(B0,1,0); LDA(At,1,0); WAIT_V(2); BAR; WAIT_L(0); MMA(0,0,At,B0); BAR;
    LDB(B1,1,1); WAIT_V(0); BAR; WAIT_L(0); MMA(0,1,At,B1); BAR;
    LDA(At,1,1); BAR; WAIT_L(0); MMA(1,0,At,B0); MMA(1,1,At,B1); BAR; }
  if (wr == 0) BAR;
  __syncthreads();
#undef SA
#undef SB
#undef STAGE
#undef STAGE_
#undef STAGE_A
#undef STAGE_Bt
#undef LDA
#undef LDB
#undef MMA
}

template <class Epi>
DI void gemm_tile(const u16* __restrict__ A, int lda, const u16* __restrict__ Bt, int ldb, int K, int brow, int bcol, char* smem, Epi& epi) {
  f32x4 acc[2][2][4][2];
  gemm_kloop<true>(A, lda, Bt, ldb, K, brow, bcol, smem, acc, otid());
  const int tid = otid();
  const int wid = tid >> 6, lane = tid & 63, wr = wid >> 2, wc = wid & 3, fr = lane & 15, fq = lane >> 4;
  if constexpr (Epi::WHOLE) { epi.whole(acc, brow, bcol, smem, tid); } else {
  float* tile = (float*)smem;
  const int er = tid >> 2, ecs = tid & 3;
#define EPI_QUAD(ai, bj) do { \
    if constexpr (Epi::PRE) epi.pre(brow + (ai) * HALF + er, bcol + (bj) * HALF + ecs * 32); \
    _Pragma("unroll") for (int m = 0; m < 4; ++m) \
    _Pragma("unroll") for (int n = 0; n < 2; ++n) \
    _Pragma("unroll") for (int j = 0; j < 4; ++j) \
      tile[(wr * 64 + m * 16 + fq * 4 + j) * EPLD + wc * 32 + n * 16 + fr] = acc[ai][bj][m][n][j]; \
    __syncthreads(); \
    epi(brow + (ai) * HALF + er, bcol + (bj) * HALF + ecs * 32, tile + er * EPLD + ecs * 32); \
    __syncthreads(); } while (0)
  EPI_QUAD(0, 0); EPI_QUAD(0, 1); EPI_QUAD(1, 0); EPI_QUAD(1, 1);
#undef EPI_QUAD
  }
}

struct EpiProj {
  static constexpr bool WHOLE = false; static constexpr bool PRE = false;
  u16* proj;
  DI void operator()(int row, int col, const float* v) const {
    u16* dst = proj + (size_t)row * PLD + col;
    const bool gate = col >= C_GATE;
#pragma unroll
    for (int c = 0; c < 4; ++c) {
      float x[8];
#pragma unroll
      for (int j = 0; j < 8; ++j) { float t = v[c * 8 + j]; x[j] = gate ? sigmoidf(t) : t; }
      *(uint4*)(dst + c * 8) = pack8(x);
    }
  }
};
struct EpiStore {
  static constexpr bool WHOLE = false; static constexpr bool PRE = false;
  u16* dstp; int ld;
  DI void operator()(int row, int col, const float* v) const {
    u16* dst = dstp + (size_t)row * ld + col;
#pragma unroll
    for (int c = 0; c < 4; ++c) { float x[8];
#pragma unroll
      for (int j = 0; j < 8; ++j) x[j] = v[c * 8 + j];
      *(uint4*)(dst + c * 8) = pack8(x); }
  }
};
struct EpiMerge {
  static constexpr bool WHOLE = false; static constexpr bool PRE = false;
  const u16* proj; float* m32; u16* hb; int pass;
  DI void operator()(int row, int col, const float* v) const {
    const u16* g = proj + (size_t)row * PLD + C_GATE + pass * 1024 + col;
    float* m = m32 + (size_t)row * 1024 + col;
#pragma unroll
    for (int c = 0; c < 4; ++c) {
      float gv[8], x[8];
      unpack8(*(const uint4*)(g + c * 8), gv);
      if (pass > 0) ld8f(m + c * 8, x); else {
#pragma unroll
        for (int j = 0; j < 8; ++j) x[j] = 0.f; }
#pragma unroll
      for (int j = 0; j < 8; ++j) x[j] += gv[j] * v[c * 8 + j];
      if (pass == 2) *(uint4*)(hb + (size_t)row * 1024 + col + c * 8) = pack8(x);
      else st8f(m + c * 8, x);
    }
  }
};
struct EpiResid {
  static constexpr bool WHOLE = false; static constexpr bool EXCH = false; static constexpr bool PRE = true;
  float* x; const float* mod; int goff; const float* src0; const float* src1;
  float4 px[8], pg[8];
  DI void pre(int row, int col) {
    const float* g = mod + tok_group(row) * 6144 + goff + col;
    const float* sp = (row < NCTX ? src0 + (size_t)row * 1024 : src1 + (size_t)(row - NCTX) * 1024) + col;
#pragma unroll
    for (int c = 0; c < 8; ++c) { px[c] = *(const float4*)(sp + c * 4); pg[c] = *(const float4*)(g + c * 4); }
  }
  DI void operator()(int row, int col, const float* v) {
    float* xp = x + (size_t)row * 1024 + col;
#pragma unroll
    for (int c = 0; c < 8; ++c) {
      float4 xv = px[c]; const float4 gv = pg[c];
      xv.x += gv.x * v[c * 4 + 0]; xv.y += gv.y * v[c * 4 + 1]; xv.z += gv.z * v[c * 4 + 2]; xv.w += gv.w * v[c * 4 + 3];
      *(float4*)(xp + c * 4) = xv;
    }
  }
};
DI void rope16_pair(float* a, float* b, const float* cr, const float* sr, int i0) {
#pragma unroll
  for (int i = 0; i < 8; ++i) { const float c = cr[i0 + i], s = sr[i0 + i], u = a[i], w = b[i]; a[i] = u * c - w * s; b[i] = u * s + w * c; }
}
struct EpiQup {
  static constexpr bool WHOLE = false; static constexpr bool PRE = false;
  u16* proj; const float* gq; const float* cosR; const float* sinR; const float* qdss;
  DI void operator()(int row, int col, const float* v) const {
    const int head = col >> 7, cs = (col & 127) >> 5;
    const float2 qs = *(const float2*)(qdss + (size_t)row * 2);
    float ss = 0.f;
#pragma unroll
    for (int c = 0; c < 8; ++c) { const float4 t = *(const float4*)(v + c * 4); ss += t.x * t.x + t.y * t.y + t.z * t.z + t.w * t.w; }
    ss += shx<1>(ss); ss += shx<2>(ss);
    const float rq = rsqrtf((qs.x + qs.y) * (1.f / 256.f) + EPS);
    const float r = rsqrtf(ss * rq * rq * (1.f / 96.f) + EPS) * rq * (0.10206207261596575f * LOG2E);
    if (cs < 3) {
      const float* g = gq + cs * 32;
      u16* dst = proj + (size_t)row * PLD + C_MLAQ + head * 96 + cs * 32;
      const bool rope = (cs == 2) && (row >= NCTX);
      const int pos = (row - NCTX) & 2047;
      const float* cr = cosR + pos * 16; const float* sr = sinR + pos * 16;
#pragma unroll
      for (int c = 0; c < 2; ++c) {
        float a[8], b[8];
#pragma unroll
        for (int j = 0; j < 8; ++j) { a[j] = v[c * 8 + j] * r * g[c * 8 + j]; b[j] = v[16 + c * 8 + j] * r * g[16 + c * 8 + j]; }
        if (rope) rope16_pair(a, b, cr, sr, c * 8);
        *(uint4*)(dst + c * 8) = pack8(a);
        *(uint4*)(dst + 16 + c * 8) = pack8(b);
      }
    }
  }
};
struct EpiKvup {
  static constexpr bool WHOLE = false; static constexpr bool PRE = false;
  u16* mk; u16* mv; const float* kpeb; const float* gk; const float* cosR; const float* sinR;
  DI void operator()(int row, int col, const float* v) const {
    const int head = col >> 7, cs = (col & 127) >> 5;
    const float* kp = kpeb + (size_t)row * 32;
    float ss = 0.f;
    if (cs < 2) {
#pragma unroll
      for (int c = 0; c < 8; ++c) { const float4 t = *(const float4*)(v + c * 4); ss += t.x * t.x + t.y * t.y + t.z * t.z + t.w * t.w; }
    } else if (cs == 2) {
#pragma unroll
      for (int c = 0; c < 8; ++c) { const float4 t = *(const float4*)(kp + c * 4); ss += t.x * t.x + t.y * t.y + t.z * t.z + t.w * t.w; }
    }
    ss += shx<1>(ss); ss += shx<2>(ss);
    const float r = rsqrtf(ss * (1.f / 96.f) + EPS);
    if (cs <= 2) {
      const float* g = gk + cs * 32;
      bool rope = false; int pos = 0;
      if (cs == 2 && row >= NCTX) { const int kp = (row - NCTX) % SLAT; rope = kp >= PAST; pos = kp - PAST; }
      const float* cr = cosR + pos * 16; const float* sr = sinR + pos * 16;
      u16* dst = mk + (size_t)row * 768 + head * 96 + cs * 32;
#pragma unroll
      for (int c = 0; c < 2; ++c) {
        float a[8], b[8];
#pragma unroll
        for (int j = 0; j < 8; ++j) {
          const float s0 = cs == 2 ? kp[c * 8 + j] : v[c * 8 + j], s1 = cs == 2 ? kp[16 + c * 8 + j] : v[16 + c * 8 + j];
          a[j] = s0 * r * g[c * 8 + j]; b[j] = s1 * r * g[16 + c * 8 + j]; }
        if (rope) rope16_pair(a, b, cr, sr, c * 8);
        *(uint4*)(dst + c * 8) = pack8(a);
        *(uint4*)(dst + 16 + c * 8) = pack8(b);
      }
    }
    if (cs >= 2) {
      u16* dst = mv + (size_t)row * 512 + head * 64 + (cs - 2) * 32;
#pragma unroll
      for (int c = 0; c < 4; ++c) { float y[8];
#pragma unroll
        for (int j = 0; j < 8; ++j) y[j] = v[c * 8 + j];
        *(uint4*)(dst + c * 8) = pack8(y); }
    }
  }
};


DI void st32bf(u16* dst, const float* y) {
#pragma unroll
  for (int c = 0; c < 4; ++c) *(uint4*)(dst + c * 8) = pack8(y + c * 8);
}
DI void st32f(float* dst, const float* y) {
#pragma unroll
  for (int c = 0; c < 8; ++c) *(float4*)(dst + c * 4) = make_float4(y[c * 4], y[c * 4 + 1], y[c * 4 + 2], y[c * 4 + 3]);
}
DI void headnorm32(const float* v, const float* gain, int hh, bool rope, const float* cr, const float* sr, float scale, u16* dbf, float* df32) {
  float4 c4[8], s4[8];
  if (rope) {
#pragma unroll
    for (int c = 0; c < 8; ++c) { c4[c] = *(const float4*)(cr + c * 4); s4[c] = *(const float4*)(sr + c * 4); }
  }
  float ss = 0.f;
#pragma unroll
  for (int c = 0; c < 8; ++c) { const float4 t = *(const float4*)(v + c * 4); ss += t.x * t.x + t.y * t.y + t.z * t.z + t.w * t.w; }
  ss += shx<1>(ss);
  const float r = rsqrtf(ss * (1.f / 64.f) + EPS);
  const float* g = gain + hh * 32;
#pragma unroll
  for (int c = 0; c < 4; ++c) {
    float y[8];
#pragma unroll
    for (int j = 0; j < 8; ++j) y[j] = v[c * 8 + j] * r * g[c * 8 + j];
    if (rope) {
      float pv[8];
#pragma unroll
      for (int j = 0; j < 8; ++j) pv[j] = shx<1>(y[j]);
      const float cs[8] = {c4[2*c].x, c4[2*c].y, c4[2*c].z, c4[2*c].w, c4[2*c+1].x, c4[2*c+1].y, c4[2*c+1].z, c4[2*c+1].w};
      const float sn[8] = {s4[2*c].x, s4[2*c].y, s4[2*c].z, s4[2*c].w, s4[2*c+1].x, s4[2*c+1].y, s4[2*c+1].z, s4[2*c+1].w};
#pragma unroll
      for (int j = 0; j < 8; ++j) y[j] = hh == 0 ? (y[j] * cs[j] - pv[j] * sn[j]) : (pv[j] * sn[j] + y[j] * cs[j]);
    }
#pragma unroll
    for (int j = 0; j < 8; ++j) y[j] *= scale;
    *(uint4*)(dbf + c * 8) = pack8(y);
    if (df32) st8f(df32 + c * 8, y);
  }
}
DI void copy32(const float* v, u16* dbf, float* df32) {
#pragma unroll
  for (int c = 0; c < 4; ++c) {
    float y[8];
#pragma unroll
    for (int j = 0; j < 8; ++j) y[j] = v[c * 8 + j];
    *(uint4*)(dbf + c * 8) = pack8(y);
    if (df32) st8f(df32 + c * 8, y);
  }
}
struct EpiProj2 {
  static constexpr bool WHOLE = false; static constexpr bool PRE = false;
  u16* proj; u16* dk; u16* dv; u16* gk; u16* gv; u16* ckvn; float* kpeb; float* qdss; float* out;
  const float* g_dqk; const float* g_mq; const float* g_mkv; const float* g_gqk; const float* cosH; const float* sinH; int l;
  DI void operator()(int row, int col, const float* v) const {
    if (col >= C_GATE) {
      u16* dst = proj + (size_t)row * PLD + col;
#pragma unroll
      for (int c = 0; c < 4; ++c) { float x[8];
#pragma unroll
        for (int j = 0; j < 8; ++j) x[j] = sigmoidf(v[c * 8 + j]);
        *(uint4*)(dst + c * 8) = pack8(x); }
      return;
    }
    const bool ctx = row < NCTX;
    int kvrow, pos; size_t orow = 0;
    if (ctx) { kvrow = row; pos = 0; orow = ((size_t)(row >> 8) * 4 + l) * 256 + (row & 255); }
    else { const int s = (row - NCTX) >> 11; pos = (row - NCTX) & 2047; kvrow = NCTX + s * SLAT + PAST + pos; }
    const float* cr = cosH + pos * 32; const float* sr = sinH + pos * 32;
    const int hh = (col >> 5) & 1;
    if (col < C_AK) {
      headnorm32(v, g_dqk, hh, !ctx, cr, sr, 0.125f * LOG2E, proj + (size_t)row * PLD + col, nullptr);
    } else if (col < C_AV) {
      headnorm32(v, g_dqk + 64, hh, !ctx, cr, sr, 1.f, dk + (size_t)kvrow * 512 + (col - C_AK), ctx ? out + O_NDK + orow * 512 + (col - C_AK) : nullptr);
    } else if (col < C_BQD) {
      copy32(v, dv + (size_t)kvrow * 512 + (col - C_AV), ctx ? out + O_NDV + orow * 512 + (col - C_AV) : nullptr);
    } else if (col < C_CQ) {
      float ss = 0.f;
#pragma unroll
      for (int c = 0; c < 8; ++c) { const float4 t = *(const float4*)(v + c * 4); ss += t.x * t.x + t.y * t.y + t.z * t.z + t.w * t.w; }
      ss += shx<1>(ss); ss += shx<2>(ss);
      if ((col & 127) == 0) qdss[(size_t)row * 2 + ((col - C_BQD) >> 7)] = ss;
      const float* g = g_mq + (col - C_BQD);
      u16* dst = proj + (size_t)row * PLD + col;
#pragma unroll
      for (int c = 0; c < 4; ++c) { float y[8];
#pragma unroll
        for (int j = 0; j < 8; ++j) y[j] = v[c * 8 + j] * g[c * 8 + j];
        *(uint4*)(dst + c * 8) = pack8(y); }
    } else if (col < C_CK) {
      headnorm32(v, g_gqk, hh, !ctx, cr, sr, 0.125f * LOG2E, proj + (size_t)row * PLD + col, nullptr);
    } else if (col < C_CV) {
      headnorm32(v, g_gqk + 64, hh, !ctx, cr, sr, 1.f, gk + (size_t)kvrow * 128 + (col - C_CK), ctx ? out + O_NGK + orow * 128 + (col - C_CK) : nullptr);
    } else if (col < C_CKV) {
      copy32(v, gv + (size_t)kvrow * 128 + (col - C_CV), ctx ? out + O_NGV + orow * 128 + (col - C_CV) : nullptr);
    } else if (col < C_KPE) {
      float ss = 0.f;
#pragma unroll
      for (int c = 0; c < 8; ++c) { const float4 t = *(const float4*)(v + c * 4); ss += t.x * t.x + t.y * t.y + t.z * t.z + t.w * t.w; }
      ss += shx<1>(ss); ss += shx<2>(ss);
      const float r = rsqrtf(ss * (1.f / 128.f) + EPS);
      const float* g = g_mkv + (col - C_CKV);
      u16* dst = ckvn + (size_t)kvrow * 256 + (col - C_CKV);
      unsigned zz = 0u; asm volatile("" : "+v"(zz));
#pragma unroll
      for (int c = 0; c < 4; ++c) { float y[8], w[8];
#pragma unroll
        for (int j = 0; j < 8; ++j) { w[j] = v[c * 8 + j]; y[j] = w[j] * r * g[c * 8 + j]; }
        *(uint4*)(dst + c * 8) = pack8(y);
        *(uint4*)(dst + 128 + c * 8) = make_uint4(zz, zz, zz, zz);
        if (ctx) st8f(out + O_NCKV + orow * 128 + (col - C_CKV) + c * 8, w); }
    } else if (col == C_KPE) {
#pragma unroll
      for (int c = 0; c < 4; ++c) { float w[8];
#pragma unroll
        for (int j = 0; j < 8; ++j) w[j] = v[c * 8 + j];
        st8f(kpeb + (size_t)kvrow * 32 + c * 8, w);
        if (ctx) st8f(out + O_NKPE + orow * 32 + c * 8, w); }
    }
  }
};

DI void conv8(const float* xm, const float* x0, const float* xp, const float* ym, const float* y0, const float* yp,
              const float* wa0, const float* wa1, const float* wa2, const float* ba, const float* wg0, const float* wg1, const float* wg2, const float* bg, float* o) {
#pragma unroll
  for (int q = 0; q < 8; ++q) {
    const float av = xm[q] * wa0[q] + x0[q] * wa1[q] + xp[q] * wa2[q] + ba[q];
    const float gv = ym[q] * wg0[q] + y0[q] * wg1[q] + yp[q] * wg2[q] + bg[q];
    o[q] = av * siluf(gv);
  }
}
struct EpiConv {
  static constexpr bool WHOLE = true; static constexpr bool PRE = false;
  static constexpr int TLD = 264;
  u16* act; u16* halo; const float* cw; const float* cb;
  DI void whole(f32x4 (&acc)[2][2][4][2], int brow, int bcol, char* smem, int tid) const {
    u16* tl = (u16*)smem;
    const int wid = tid >> 6, lane = tid & 63, wr = wid >> 2, wc = wid & 3, fr = lane & 15, fq = lane >> 4;
    const int pm = brow >> 8, pn = bcol >> 8;
    const bool lat = brow >= NCTX;
    const int c = tid & 15, r0 = tid >> 4;
    const int jg = pn * 128 + c * 8;
    float wa0[8], wa1[8], wa2[8], ba[8], wg0[8], wg1[8], wg2[8], bg[8];
    ld8f(cw + jg, wa0); ld8f(cw + UP + jg, wa1); ld8f(cw + 2 * UP + jg, wa2); ld8f(cb + jg, ba);
    ld8f(cw + DFF + jg, wg0); ld8f(cw + UP + DFF + jg, wg1); ld8f(cw + 2 * UP + DFF + jg, wg2); ld8f(cb + DFF + jg, bg);
#pragma unroll
    for (int ai = 0; ai < 2; ++ai)
#pragma unroll
      for (int bj = 0; bj < 2; ++bj)
#pragma unroll
        for (int m = 0; m < 4; ++m)
#pragma unroll
          for (int n = 0; n < 2; ++n)
#pragma unroll
            for (int j = 0; j < 4; ++j)
              tl[(ai * 128 + wr * 64 + m * 16 + fq * 4 + j) * TLD + bj * 128 + wc * 32 + n * 16 + fr] = (u16)(pk2(acc[ai][bj][m][n][j], 0.f) & 0xffffu);
    __syncthreads();
    const uint4 z4 = make_uint4(0, 0, 0, 0);
#pragma unroll 2
    for (int k = 0; k < 8; ++k) {
      const int r = r0 + 32 * k;
      if (lat && (r == 0 || r == 255)) continue;
      const u16* base = tl + r * TLD + c * 8;
      const uint4 am = r > 0 ? *(const uint4*)(base - TLD) : z4, gm = r > 0 ? *(const uint4*)(base - TLD + 128) : z4;
      const uint4 a0 = *(const uint4*)base, g0 = *(const uint4*)(base + 128);
      const uint4 ap = r < 255 ? *(const uint4*)(base + TLD) : z4, gp = r < 255 ? *(const uint4*)(base + TLD + 128) : z4;
      float xm[8], x0[8], xp[8], ym[8], y0[8], yp[8], o[8];
      unpack8(am, xm); unpack8(a0, x0); unpack8(ap, xp); unpack8(gm, ym); unpack8(g0, y0); unpack8(gp, yp);
      conv8(xm, x0, xp, ym, y0, yp, wa0, wa1, wa2, ba, wg0, wg1, wg2, bg, o);
      *(uint4*)(act + (size_t)(brow + r) * DFF + jg) = pack8(o);
    }
    if (lat && tid < 128) {
      const int rs = tid >> 5, ch = tid & 31;
      const int row = rs < 2 ? rs : 252 + rs;
      *(uint4*)(halo + ((size_t)((pm - 32) * 22 + pn) * 4 + rs) * 256 + ch * 8) = *(const uint4*)(tl + row * TLD + ch * 8);
    }
    __syncthreads();
  }
  DI void operator()(int, int, const float*) const {}
};
DI void conv_fixup(u16* act, const u16* halo, const float* cw, const float* cb, int pm, int tid) {
  if (pm < 32) return;
  const int lm = pm - 32;
  for (int it = tid; it < 704; it += 512) {
    const int rsel = it / 352, j = (it % 352) * 8, pn = j >> 7, jj = j & 127;
    const u16* hb = halo + (size_t)(lm * 22 + pn) * 1024;
    const uint4 z4 = make_uint4(0, 0, 0, 0);
    uint4 am, gm, a0, g0, ap, gp;
    if (rsel == 0) {
      const bool first = (lm & 7) == 0;
      const u16* hp = halo + (size_t)((lm - 1) * 22 + pn) * 1024 + 3 * 256;
      am = first ? z4 : *(const uint4*)(hp + jj); gm = first ? z4 : *(const uint4*)(hp + 128 + jj);
      a0 = *(const uint4*)(hb + jj); g0 = *(const uint4*)(hb + 128 + jj);
      ap = *(const uint4*)(hb + 256 + jj); gp = *(const uint4*)(hb + 256 + 128 + jj);
    } else {
      const bool last = (lm & 7) == 7;
      const u16* hn = halo + (size_t)((lm + 1) * 22 + pn) * 1024;
      am = *(const uint4*)(hb + 512 + jj); gm = *(const uint4*)(hb + 512 + 128 + jj);
      a0 = *(const uint4*)(hb + 768 + jj); g0 = *(const uint4*)(hb + 768 + 128 + jj);
      ap = last ? z4 : *(const uint4*)(hn + jj); gp = last ? z4 : *(const uint4*)(hn + 128 + jj);
    }
    float wa0[8], wa1[8], wa2[8], ba[8], wg0[8], wg1[8], wg2[8], bg[8];
    ld8f(cw + j, wa0); ld8f(cw + UP + j, wa1); ld8f(cw + 2 * UP + j, wa2); ld8f(cb + j, ba);
    ld8f(cw + DFF + j, wg0); ld8f(cw + UP + DFF + j, wg1); ld8f(cw + 2 * UP + DFF + j, wg2); ld8f(cb + DFF + j, bg);
    float xm[8], x0[8], xp[8], ym[8], y0[8], yp[8], o[8];
    unpack8(am, xm); unpack8(a0, x0); unpack8(ap, xp); unpack8(gm, ym); unpack8(g0, y0); unpack8(gp, yp);
    conv8(xm, x0, xp, ym, y0, yp, wa0, wa1, wa2, ba, wg0, wg1, wg2, bg, o);
    *(uint4*)(act + (size_t)(pm * 256 + (rsel ? 255 : 0)) * DFF + j) = pack8(o);
  }
}
struct NoPre { DI void operator()(int, int, int) const {} };
struct PreCkv {
  const float* cckv; const float* ckpe; const float* g_mkv; u16* ckvn; float* kpeb; int l;
  DI void operator()(int pm, int, int tid) const {
    const int s = (pm - 32) / 9, lane = tid & 63, w = tid >> 6;
#pragma unroll 2
    for (int it = 0; it < 32; ++it) {
      const int kp = w + 8 * it, kvrow = NCTX + s * SLAT + kp;
      const size_t crow = (size_t)(s * 4 + l) * 256 + kp;
      float x[8]; float ss = 0.f;
      if (lane < 16) { ld8f(cckv + crow * 128 + lane * 8, x);
#pragma unroll
        for (int j = 0; j < 8; ++j) ss += x[j] * x[j]; }
      ss = wave_sum(ss);
      const float rr = rsqrtf(ss * (1.f / 128.f) + EPS);
      if (lane < 16) {
#pragma unroll
        for (int j = 0; j < 8; ++j) x[j] = x[j] * rr * g_mkv[lane * 8 + j];
        *(uint4*)(ckvn + (size_t)kvrow * 256 + lane * 8) = pack8(x);
      } else if (lane < 32) {
        unsigned zz = 0u; asm volatile("" : "+v"(zz)); *(uint4*)(ckvn + (size_t)kvrow * 256 + lane * 8) = make_uint4(zz, zz, zz, zz);
      }
      if (lane < 4) { ld8f(ckpe + crow * 32 + lane * 8, x); st8f(kpeb + (size_t)kvrow * 32 + lane * 8, x); }
    }
  }
};
struct PreFix { u16* act; const u16* halo; const float* cw; const float* cb; DI void operator()(int pm, int, int tid) const { conv_fixup(act, halo, cw, cb, pm, tid); } };


constexpr int GLD = 264;
DI void gate_half_to_lds(const u16* __restrict__ proj, int gi, int brow, int bcol, int ai, u16* dst, int tid) {
  const u16* g = proj + (size_t)(brow + ai * 128) * PLD + C_GATE + gi * 1024 + bcol;
  int t = tid; asm volatile("" : "+v"(t));
  const unsigned off = (unsigned)((t >> 5) * PLD + (t & 31) * 8);
  const unsigned lo = (unsigned)((t >> 5) * GLD + (t & 31) * 8);
#pragma unroll
  for (int k2 = 0; k2 < 2; ++k2) {
    const uint4 v0 = *(const uint4*)(g + (size_t)(off + (unsigned)((k2 * 4 + 0) * 16 * PLD)));
    const uint4 v1 = *(const uint4*)(g + (size_t)(off + (unsigned)((k2 * 4 + 1) * 16 * PLD)));
    const uint4 v2 = *(const uint4*)(g + (size_t)(off + (unsigned)((k2 * 4 + 2) * 16 * PLD)));
    const uint4 v3 = *(const uint4*)(g + (size_t)(off + (unsigned)((k2 * 4 + 3) * 16 * PLD)));
    *(uint4*)(dst + lo + (k2 * 4 + 0) * 16 * GLD) = v0;
    *(uint4*)(dst + lo + (k2 * 4 + 1) * 16 * GLD) = v1;
    *(uint4*)(dst + lo + (k2 * 4 + 2) * 16 * GLD) = v2;
    *(uint4*)(dst + lo + (k2 * 4 + 3) * 16 * GLD) = v3;
    __builtin_amdgcn_sched_barrier(0);
  }
}
DI void scale_acc(f32x4 (&acc)[2][2][4][2], const u16* proj, int gnum, int gden, int brow, int bcol, char* smem, int tid) {
  u16* l0 = (u16*)smem; u16* l1 = l0 + 128 * GLD;
#pragma unroll
  for (int ai = 0; ai < 2; ++ai) {
    if (gnum >= 0) gate_half_to_lds(proj, gnum, brow, bcol, ai, l0, tid);
    if (gden >= 0) gate_half_to_lds(proj, gden, brow, bcol, ai, l1, tid);
    __syncthreads();
    int t = tid; asm volatile("" : "+v"(t));
    const int wid = t >> 6, lane = t & 63, wr = wid >> 2, wc = wid & 3, fr = lane & 15, fq = lane >> 4;
    unsigned b0 = (unsigned)(((wr * 64 + fq * 4) * GLD + wc * 32 + fr) * 2);
    unsigned b1 = b0 + 128u * GLD * 2u;
    asm volatile("" : "+v"(b0), "+v"(b1));
#pragma unroll
    for (int bj = 0; bj < 2; ++bj)
#pragma unroll
      for (int m = 0; m < 4; ++m) {
#pragma unroll
        for (int n = 0; n < 2; ++n)
#pragma unroll
          for (int j = 0; j < 4; ++j) {
            const int co = ((m * 16 + j) * GLD + bj * 128 + n * 16) * 2;
            float f = 1.f;
            if (gnum >= 0) f = fmaxf(bf2f(*(const u16*)(smem + b0 + co)), 1e-6f);
            if (gden >= 0) f = f * __builtin_amdgcn_rcpf(fmaxf(bf2f(*(const u16*)(smem + b1 + co)), 1e-6f));
            acc[ai][bj][m][n][j] *= f;
          }
        asm volatile("" : "+v"(acc[ai][bj][m][0]), "+v"(acc[ai][bj][m][1]));
      }
    __syncthreads();
  }
}
DI void merge_tile(const u16* ob, const u16* wb, const u16* proj, u16* hb, int brow, int bcol, char* smem) {
  f32x4 acc[2][2][4][2];
  gemm_kloop<true>(ob, 1536, wb, 512, 512, brow, bcol, smem, acc, otid());
  scale_acc(acc, proj, 0, 1, brow, bcol, smem, otid());
  gemm_kloop<false>(ob + 512, 1536, wb + (size_t)1024 * 512, 512, 512, brow, bcol, smem, acc, otid());
  scale_acc(acc, proj, 1, 2, brow, bcol, smem, otid());
  gemm_kloop<false>(ob + 1024, 1536, wb + (size_t)2 * 1024 * 512, 512, 512, brow, bcol, smem, acc, otid());
  scale_acc(acc, proj, 2, -1, brow, bcol, smem, otid());
  const int tid = otid();
  u16* tl = (u16*)smem;
  int t2 = tid; asm volatile("" : "+v"(t2));
  const int wid = t2 >> 6, lane = t2 & 63, wr = wid >> 2, wc = wid & 3, fr = lane & 15, fq = lane >> 4;
#pragma unroll
  for (int ai = 0; ai < 2; ++ai)
#pragma unroll
    for (int bj = 0; bj < 2; ++bj)
#pragma unroll
      for (int m = 0; m < 4; ++m)
#pragma unroll
        for (int n = 0; n < 2; ++n)
#pragma unroll
          for (int j = 0; j < 4; ++j)
            tl[(ai * 128 + wr * 64 + m * 16 + fq * 4 + j) * GLD + bj * 128 + wc * 32 + n * 16 + fr] = (u16)(pk2(acc[ai][bj][m][n][j], 0.f) & 0xffffu);
  __syncthreads();
#pragma unroll
  for (int k = 0; k < 16; ++k) {
    const int id = tid + 512 * k, row = id >> 5, ch = id & 31;
    *(uint4*)(hb + (size_t)(brow + row) * 1024 + bcol + ch * 8) = *(const uint4*)(tl + row * GLD + ch * 8);
  }
  __syncthreads();
}
DI void merge_phase(const u16* ob, const u16* wb, const u16* proj, u16* hb, char* smem, int vb) {
  const int nb = ogrid();
  const int nx = nb >> 5;
  int team, rnk, nteam, tsz;
  if (nx * 32 == nb) { team = vb >> 5; rnk = vb & 31; nteam = nx; tsz = 32; } else { team = 0; rnk = vb; nteam = 1; tsz = nb; }
  const int lo = (256 * team) / nteam, hi = (256 * (team + 1)) / nteam;
  for (int t = lo + rnk; t < hi; t += tsz) {
    const int g = t >> 5, w = t & 31;
    const int pm = g * 8 + (w & 7), pn = w >> 3;
    merge_tile(ob, wb, proj, hb, pm * BM, pn * BM, smem);
  }
}

template <class Epi, class Pre = NoPre, int MAP = 0>
DI void gemm_phase(const u16* A, int lda, const u16* Bt, int ldb, int K, int nM, int nN, char* smem, Epi& epi, int tile0, int ntot, int vb, Pre pre = Pre()) {
  const int nb = ogrid();
  const int nx = nb >> 5;
  int team, rnk, nteam, tsz;
  if (nx * 32 == nb) { team = vb >> 5; rnk = vb & 31; nteam = nx; tsz = 32; } else { team = 0; rnk = vb; nteam = 1; tsz = nb; }
  const int lo = __builtin_amdgcn_readfirstlane((ntot * team) / nteam), hi = __builtin_amdgcn_readfirstlane((ntot * (team + 1)) / nteam);
  for (int t = lo + rnk; t < hi; t += tsz) {
    const int tt = t - tile0;
    if (tt < 0 || tt >= nM * nN) continue;
    const int gsz8 = 8 * nN, g = __builtin_amdgcn_readfirstlane(tt / gsz8), w = tt - g * gsz8;
    const int gm = min(8, nM - g * 8);
    const int pn = __builtin_amdgcn_readfirstlane(w / gm); int pm = g * 8 + (w - pn * gm);
    if (MAP == 1) pm = pm < 32 ? pm : 32 + 9 * ((pm - 32) >> 3) + 1 + ((pm - 32) & 7);
    if (MAP == 2) pm = 32 + 9 * pm;
    pre(pm, pn, otid());
    gemm_tile(A, lda, Bt, ldb, K, pm * BM, pn * BM, smem, epi);
  }
}

DI void convT(const float* __restrict__ src, int K, int N, u16* __restrict__ dst, int Nd, int Kd, int mode, char* smem, int rot) {
  float* t = (float*)smem;
  const int tn = Nd >> 6, tk = Kd >> 6, ntile = tn * tk;
  const int tid = otid();
  const int nb_ = ogrid();
  int tt0 = obid() + rot; if (tt0 >= nb_) tt0 -= nb_;
  for (int tt = tt0; tt < ntile; tt += nb_) {
    const int n0 = (tt % tn) << 6, k0 = (tt / tn) << 6;
    __syncthreads();
    {
      const int kr = tid >> 4, nc = (tid & 15) * 4;
      const int nd = n0 + nc;
      int sn;
      if (mode == 0) sn = nd < N ? nd : -1;
      else if (mode == 1) { const int hh = nd >> 7, j = nd & 127; sn = j < 96 ? hh * 96 + j : -1; }
      else if (mode == 3) sn = nd < 1792 ? nd : nd < 2560 ? nd + 160 : nd < 2720 ? nd - 768 : nd < 2816 ? -1 : nd - 96;
      else sn = ((nd & 255) >> 7) * DFF + (nd >> 8) * 128 + (nd & 127);
      float4 v0 = make_float4(0.f, 0.f, 0.f, 0.f), v1 = v0;
      if (sn >= 0) {
        if (k0 + kr < K) v0 = *(const float4*)(src + (size_t)(k0 + kr) * N + sn);
        if (k0 + kr + 32 < K) v1 = *(const float4*)(src + (size_t)(k0 + kr + 32) * N + sn);
      }
      float* t0 = t + kr * 65 + nc; float* t1 = t + (kr + 32) * 65 + nc;
      t0[0] = v0.x; t0[1] = v0.y; t0[2] = v0.z; t0[3] = v0.w;
      t1[0] = v1.x; t1[1] = v1.y; t1[2] = v1.z; t1[3] = v1.w;
    }
    __syncthreads();
    {
      const int nr = tid >> 3, kc = (tid & 7) * 8;
      float x[8];
#pragma unroll
      for (int j = 0; j < 8; ++j) x[j] = t[(kc + j) * 65 + nr];
      *(uint4*)(dst + (size_t)(n0 + nr) * Kd + k0 + kc) = pack8(x);
    }
  }
}

DI void convert_layer(const Params& p, int l, char* smem) {
  char* ws = ows(p.ws);
  convT(p.in[13] + (size_t)l * 1024 * IN_COLS, 1024, IN_COLS, (u16*)(ws + WS_WIN), PLD, 1024, 3, smem, 0);
  convT(p.in[28] + (size_t)l * 1024 * UP, 1024, UP, (u16*)(ws + WS_WUP), UP, 1024, 2, smem, 64);
  convT(p.in[31] + (size_t)l * DFF * 1024, DFF, 1024, (u16*)(ws + WS_WD), 1024, DFF, 0, smem, 192);
  convT(p.in[26] + (size_t)l * 1024 * 1024, 1024, 1024, (u16*)(ws + WS_WO), 1024, 1024, 0, smem, 128);
  convT(p.in[23] + (size_t)l * 512 * 1024, 512, 1024, (u16*)(ws + WS_WB), 1024, 512, 0, smem, 0);
  convT(p.in[24] + (size_t)l * 512 * 1024, 512, 1024, (u16*)(ws + WS_WB) + 1024 * 512, 1024, 512, 0, smem, 128);
  convT(p.in[25] + (size_t)l * 512 * 1024, 512, 1024, (u16*)(ws + WS_WB) + 2 * 1024 * 512, 1024, 512, 0, smem, 0);
  convT(p.in[18] + (size_t)l * 256 * 768, 256, 768, (u16*)(ws + WS_WQU), 1024, 256, 1, smem, 128);
  convT(p.in[20] + (size_t)l * 128 * 1024, 128, 1024, (u16*)(ws + WS_WKV), 1024, 256, 0, smem, 192);
}

DI void phase0(const Params& p, char* smem) {
  const int bid_ = obid(), nb_ = ogrid();
  const int tid = otid(), gtid = bid_ * 512 + tid, nth = nb_ * 512;
  char* ws = ows(p.ws);
  {
    float* rp = (float*)(ws + WS_ROPE);
    for (int i = gtid; i < 2048 * 48; i += nth) {
      int pos, j, quarter; float* cd; float* sd;
      if (i < 2048 * 32) { pos = i >> 5; j = i & 31; quarter = 16; cd = rp + i; sd = rp + 65536 + i; }
      else { int k = i - 65536; pos = k >> 4; j = k & 15; quarter = 8; cd = rp + 131072 + k; sd = rp + 131072 + 32768 + k; }
      const int row = pos >> 6, colp = pos & 63;
      const int jj = j < quarter ? j : j - quarter;
      const float inv = 1.0f / exp2f((float)jj / (float)quarter * 13.287712379549449f);
      const float ang = (float)(j < quarter ? row : colp) * inv;
      const float rev = ang * 0.15915494309189535f;
      const float fr = rev - rintf(rev);
      const double a2 = (double)ang - (double)rintf(rev) * 6.283185307179586;
      (void)fr;
      *cd = __cosf((float)a2); *sd = __sinf((float)a2);
    }
  }
  {
    float* sc = (float*)smem;
    float* modp = (float*)(ws + WS_MODP);
    for (int it = bid_; it < 4 * 12 * 16; it += nb_) {
      const int l = it / 192, cc = (it / 16) % 12, kc = it & 15;
      __syncthreads();
      if (tid < 5 * 64) {
        const int g = tid >> 6, k = kc * 64 + (tid & 63);
        const float cv = g == 0 ? p.in[9][k] : p.in[2][(g - 1) * 1024 + k];
        sc[tid] = siluf(cv);
      }
      __syncthreads();
      const int n = cc * 512 + tid;
      const float* w = p.in[10] + ((size_t)l * 1024 + kc * 64) * 6144 + n;
      float a0 = 0, a1 = 0, a2 = 0, a3 = 0, a4 = 0;
#pragma unroll
      for (int kb = 0; kb < 4; ++kb) {
        float wv[16];
#pragma unroll
        for (int k = 0; k < 16; ++k) wv[k] = w[(size_t)(kb * 16 + k) * 6144];
#pragma unroll
        for (int k = 0; k < 16; ++k) {
          const int kk = kb * 16 + k;
          a0 += sc[kk] * wv[k]; a1 += sc[64 + kk] * wv[k]; a2 += sc[128 + kk] * wv[k]; a3 += sc[192 + kk] * wv[k]; a4 += sc[256 + kk] * wv[k];
        }
      }
      float* o = modp + ((size_t)(kc * 4 + l) * 5) * 6144 + n;
      o[0] = a0; o[6144] = a1; o[2 * 6144] = a2; o[3 * 6144] = a3; o[4 * 6144] = a4;
    }
  }
}
DI void phase0b(const Params& p) {
  const int gtid = obid() * 512 + otid(), nth = ogrid() * 512;
  char* ws = ows(p.ws);
  const float* modp = (const float*)(ws + WS_MODP);
  float* mod = (float*)(ws + WS_MOD);
  for (int i = gtid; i < 4 * 5 * 6144; i += nth) {
    const int l = i / (5 * 6144), n = i % 6144;
    float s = p.in[11][l * 6144 + n];
#pragma unroll
    for (int kc = 0; kc < 16; ++kc) s += modp[(size_t)kc * 4 * 5 * 6144 + i];
    mod[i] = s;
  }
}

DI void norm_mod(const Params& p, const float* gain, const float* modl, int shoff, int scoff, const float* src0, const float* src1) {
  const int tid = otid(), lane = tid & 63;
  const int gw = (obid() * 512 + tid) >> 6, nw = (ogrid() * 512) >> 6;
  u16* h = (u16*)(ows(p.ws) + WS_H);
  for (int t = gw; t < NTOK; t += nw) {
    const float* xr = t < NCTX ? src0 + (size_t)t * 1024 : src1 + (size_t)(t - NCTX) * 1024;
    float4 v[4]; float ss = 0.f;
#pragma unroll
    for (int i = 0; i < 4; ++i) { v[i] = *(const float4*)(xr + i * 256 + lane * 4); ss += v[i].x*v[i].x + v[i].y*v[i].y + v[i].z*v[i].z + v[i].w*v[i].w; }
    ss = wave_sum(ss);
    const float r = rsqrtf(ss * (1.f / 1024.f) + EPS);
    const float* md = modl + tok_group(t) * 6144;
#pragma unroll
    for (int i = 0; i < 4; ++i) {
      const int c = i * 256 + lane * 4;
      const float4 g = *(const float4*)(gain + c), sc = *(const float4*)(md + scoff + c), sh = *(const float4*)(md + shoff + c);
      const float y0 = v[i].x * r * g.x * (1.f + sc.x) + sh.x, y1 = v[i].y * r * g.y * (1.f + sc.y) + sh.y;
      const float y2 = v[i].z * r * g.z * (1.f + sc.z) + sh.z, y3 = v[i].w * r * g.w * (1.f + sc.w) + sh.w;
      uint2 o; o.x = pk2(y0, y1); o.y = pk2(y2, y3);
      *(uint2*)(h + (size_t)t * 1024 + c) = o;
    }
  }
}

DI void headnorm_rope64(float* x, const float* gain, int lane, bool rope, const float* cr, const float* sr, float outscale) {
  float ss = 0.f;
#pragma unroll
  for (int j = 0; j < 8; ++j) ss += x[j] * x[j];
  ss += shx<1>(ss); ss += shx<2>(ss); ss += shx<4>(ss);
  const float r = rsqrtf(ss * (1.f / 64.f) + EPS);
  const int d0 = (lane & 7) * 8;
#pragma unroll
  for (int j = 0; j < 8; ++j) x[j] = x[j] * r * gain[d0 + j];
  float y[8];
#pragma unroll
  for (int j = 0; j < 8; ++j) y[j] = shx<4>(x[j]);
  if (rope) {
    const int i0 = d0 & 31;
    const bool first = (lane & 4) == 0;
#pragma unroll
    for (int j = 0; j < 8; ++j) {
      const float c = cr[i0 + j], s = sr[i0 + j];
      x[j] = first ? (x[j] * c - y[j] * s) : (y[j] * s + x[j] * c);
    }
  }
#pragma unroll
  for (int j = 0; j < 8; ++j) x[j] *= outscale;
}

DI void phase3_cached(const Params& p, int l) {
  const int tid = otid(), lane = tid & 63;
  const int gw = (obid() * 512 + tid) >> 6, nw = (ogrid() * 512) >> 6;
  char* ws = ows(p.ws);
  u16* dk = (u16*)(ws + WS_DK); u16* dv = (u16*)(ws + WS_DV);
  u16* gk = (u16*)(ws + WS_GK); u16* gv = (u16*)(ws + WS_GV);
  u16* ckvn = (u16*)(ws + WS_CKVN); float* kpeb = (float*)(ws + WS_KPE);
  const float* g_mkv = p.in[19] + l * 128;
  for (int r = NTOK + gw; r < KVROWS; r += nw) {
    {
      const int c = r - NTOK, s = c >> 8, kp = c & 255;
      const int kvrow = NCTX + s * SLAT + kp;
      const size_t crow = ((size_t)(s * 4 + l) * 256 + kp);
      float x[8];
      ld8f(p.in[3] + crow * 512 + lane * 8, x); *(uint4*)(dk + (size_t)kvrow * 512 + lane * 8) = pack8(x);
      ld8f(p.in[4] + crow * 512 + lane * 8, x); *(uint4*)(dv + (size_t)kvrow * 512 + lane * 8) = pack8(x);
      {
        float ss = 0.f;
        if (lane < 16) { ld8f(p.in[5] + crow * 128 + lane * 8, x);
#pragma unroll
          for (int j = 0; j < 8; ++j) ss += x[j] * x[j]; }
        ss = wave_sum(ss);
        const float rr = rsqrtf(ss * (1.f / 128.f) + EPS);
        if (lane < 16) {
#pragma unroll
          for (int j = 0; j < 8; ++j) x[j] = x[j] * rr * g_mkv[lane * 8 + j];
          *(uint4*)(ckvn + (size_t)kvrow * 256 + lane * 8) = pack8(x);
        } else if (lane < 32) {
          { unsigned zz = 0u; asm volatile("" : "+v"(zz)); *(uint4*)(ckvn + (size_t)kvrow * 256 + lane * 8) = make_uint4(zz, zz, zz, zz); }
        }
      }
      if (lane < 4) { ld8f(p.in[6] + crow * 32 + lane * 8, x); st8f(kpeb + (size_t)kvrow * 32 + lane * 8, x); }
      if (lane < 16) {
        ld8f(p.in[7] + crow * 128 + lane * 8, x); *(uint4*)(gk + (size_t)kvrow * 128 + lane * 8) = pack8(x);
        ld8f(p.in[8] + crow * 128 + lane * 8, x); *(uint4*)(gv + (size_t)kvrow * 128 + lane * 8) = pack8(x);
      }
    }
  }
}

DI s16x4 tr_read(const char* addr) {
  return __builtin_amdgcn_ds_read_tr16_b64_v4i16((__attribute__((address_space(3))) s16x4*)(unsigned)(size_t)addr);
}

template <int DQK, int DV, int NM>
DI void attn_item(const u16* __restrict__ Qp, int ldq, int qms, const u16* __restrict__ Kp, int ldk, int kms,
                  const u16* __restrict__ Vp, int ldv, int q0, int kv0, int S, float shift,
                  u16* __restrict__ Op, int ldo, float lam, float outmul, const float* ogain, float* __restrict__ o0s, char* smem) {
  constexpr int KSTR = DQK * 2 + 16, VSTR = DV * 2 + 16;
  constexpr int CK = DQK / 8, CV = DV / 8;
  constexpr int NKS = DQK / 16, NC = DV / 32;
  char* Kt = smem; char* Vt = smem + 14336;
  const int tid = otid(), lane = tid & 63, w = tid >> 6, r = lane & 31, h = lane >> 5;
  const int qtok = q0 + w * 32 + r;
  const int nt = S >> 6;
  const int kc0 = tid, kc1 = tid + 512;
  const int kr0 = kc0 / CK, kh0 = kc0 % CK, kr1 = kc1 / CK, kh1 = kc1 % CK;
  const bool k1ok = kc1 < 64 * CK;
  const int vr0 = kc0 / CV, vh0 = kc0 % CV, vr1 = kc1 / CV, vh1 = kc1 % CV;
  const bool v1ok = kc1 < 64 * CV;
  const int tq = (lane & 15) >> 2, tp = lane & 3, tblk = (lane >> 4) & 1;
#pragma unroll
  for (int m = 0; m < NM; ++m) {
    bf16x8 qf[NKS];
#pragma unroll
    for (int ks = 0; ks < NKS; ++ks) qf[ks] = *(const bf16x8*)(Qp + (size_t)qtok * ldq + m * qms + ks * 16 + 8 * h);
    f32x16 o[NC];
#pragma unroll
    for (int c = 0; c < NC; ++c)
#pragma unroll
      for (int i = 0; i < 16; ++i) o[c][i] = 0.f;
    float lsum = 0.f;
    const u16* Kb = Kp + m * kms;
    uint4 kreg0, kreg1 = make_uint4(0,0,0,0), vreg0, vreg1 = make_uint4(0,0,0,0);
    kreg0 = *(const uint4*)(Kb + (size_t)(kv0 + kr0) * ldk + kh0 * 8);
    if (k1ok) kreg1 = *(const uint4*)(Kb + (size_t)(kv0 + kr1) * ldk + kh1 * 8);
    vreg0 = *(const uint4*)(Vp + (size_t)(kv0 + vr0) * ldv + vh0 * 8);
    if (v1ok) vreg1 = *(const uint4*)(Vp + (size_t)(kv0 + vr1) * ldv + vh1 * 8);
    *(uint4*)(Kt + kr0 * KSTR + kh0 * 16) = kreg0;
    if (k1ok) *(uint4*)(Kt + kr1 * KSTR + kh1 * 16) = kreg1;
    *(uint4*)(Vt + vr0 * VSTR + vh0 * 16) = vreg0;
    if (v1ok) *(uint4*)(Vt + vr1 * VSTR + vh1 * 16) = vreg1;
    __syncthreads();
    for (int kt = 0; kt < nt; ++kt) {
      unsigned kofs = (unsigned)(r * KSTR + 16 * h) + (unsigned)(kt & 1) * 32768u;
      unsigned vofs = (unsigned)((4 * h + tq) * VSTR + (16 * tblk + 4 * tp) * 2) + 14336u + (unsigned)(kt & 1) * 32768u;
      asm volatile("" : "+v"(kofs), "+v"(vofs));
      const char* Kc = smem + kofs; const char* Vc = smem + vofs;
      if (kt + 1 < nt) {
        const int kb = kv0 + (kt + 1) * 64;
        kreg0 = *(const uint4*)(Kb + (size_t)(kb + kr0) * ldk + kh0 * 8);
        if (k1ok) kreg1 = *(const uint4*)(Kb + (size_t)(kb + kr1) * ldk + kh1 * 8);
        vreg0 = *(const uint4*)(Vp + (size_t)(kb + vr0) * ldv + vh0 * 8);
        if (v1ok) vreg1 = *(const uint4*)(Vp + (size_t)(kb + vr1) * ldv + vh1 * 8);
      }
      bf16x8 pf[2][2];
#pragma unroll
      for (int kb = 0; kb < 2; ++kb) {
        f32x16 s;
#pragma unroll
        for (int i = 0; i < 16; ++i) s[i] = -shift;
#pragma unroll
        for (int ks = 0; ks < NKS; ++ks) {
          const bf16x8 a = *(const bf16x8*)(Kc + kb * 32 * KSTR + ks * 32);
          s = __builtin_amdgcn_mfma_f32_32x32x16_bf16(a, qf[ks], s, 0, 0, 0);
        }
        float pv[16];
#pragma unroll
        for (int i = 0; i < 16; ++i) { pv[i] = __builtin_amdgcn_exp2f(s[i]); lsum += pv[i]; }
#pragma unroll
        for (int s2 = 0; s2 < 2; ++s2) {
          uint4 pk; pk.x = pk2(pv[8*s2+0], pv[8*s2+1]); pk.y = pk2(pv[8*s2+2], pv[8*s2+3]); pk.z = pk2(pv[8*s2+4], pv[8*s2+5]); pk.w = pk2(pv[8*s2+6], pv[8*s2+7]);
          pf[kb][s2] = __builtin_bit_cast(bf16x8, pk);
        }
      }
#pragma unroll
      for (int c = 0; c < NC; ++c)
#pragma unroll
        for (int kb = 0; kb < 2; ++kb)
#pragma unroll
          for (int s2 = 0; s2 < 2; ++s2) {
            const char* a0 = Vc + (kb * 32 + 16 * s2) * VSTR + 64 * c;
            const s16x4 lo = tr_read(a0);
            const s16x4 hi = tr_read(a0 + 8 * VSTR);
            const bf16x8 a = __builtin_shufflevector(lo, hi, 0, 1, 2, 3, 4, 5, 6, 7);
            o[c] = __builtin_amdgcn_mfma_f32_32x32x16_bf16(a, pf[kb][s2], o[c], 0, 0, 0);
            if (s2 == 1) __builtin_amdgcn_sched_barrier(0);
          }
      if (kt + 1 < nt) {
        char* Kn = Kt + ((kt + 1) & 1) * 32768; char* Vn = Vt + ((kt + 1) & 1) * 32768;
        *(uint4*)(Kn + kr0 * KSTR + kh0 * 16) = kreg0;
        if (k1ok) *(uint4*)(Kn + kr1 * KSTR + kh1 * 16) = kreg1;
        *(uint4*)(Vn + vr0 * VSTR + vh0 * 16) = vreg0;
        if (v1ok) *(uint4*)(Vn + vr1 * VSTR + vh1 * 16) = vreg1;
      }
      __syncthreads();
    }
    const float ltot = lsum + shx<32>(lsum);
    const float inv = 1.f / ltot;
    if (NM == 2 && m == 0) {
#pragma unroll
      for (int c = 0; c < NC; ++c)
#pragma unroll
        for (int g = 0; g < 4; ++g)
          *(float4*)(o0s + (size_t)qtok * 512 + 32 * c + 8 * g + 4 * h) = make_float4(o[c][4*g] * inv, o[c][4*g+1] * inv, o[c][4*g+2] * inv, o[c][4*g+3] * inv);
    } else {
      if (NM == 2) {
        float ss = 0.f;
#pragma unroll
        for (int c = 0; c < NC; ++c)
#pragma unroll
          for (int g = 0; g < 4; ++g) {
            const float4 p0 = *(const float4*)(o0s + (size_t)qtok * 512 + 32 * c + 8 * g + 4 * h);
            const float v0 = p0.x - lam * o[c][4*g] * inv, v1 = p0.y - lam * o[c][4*g+1] * inv, v2 = p0.z - lam * o[c][4*g+2] * inv, v3 = p0.w - lam * o[c][4*g+3] * inv;
            o[c][4*g] = v0; o[c][4*g+1] = v1; o[c][4*g+2] = v2; o[c][4*g+3] = v3;
            ss += v0 * v0 + v1 * v1 + v2 * v2 + v3 * v3;
          }
        ss += shx<32>(ss);
        const float rr = rsqrtf(ss * (1.f / (float)DV) + EPS) * outmul;
#pragma unroll
        for (int c = 0; c < NC; ++c)
#pragma unroll
          for (int g = 0; g < 4; ++g) {
            const int dvb = 32 * c + 8 * g + 4 * h;
            const float4 gg = *(const float4*)(ogain + dvb);
            uint2 st; st.x = pk2(o[c][4*g] * rr * gg.x, o[c][4*g+1] * rr * gg.y); st.y = pk2(o[c][4*g+2] * rr * gg.z, o[c][4*g+3] * rr * gg.w);
            *(uint2*)(Op + (size_t)qtok * ldo + dvb) = st;
          }
      } else {
#pragma unroll
        for (int c = 0; c < NC; ++c)
#pragma unroll
          for (int g = 0; g < 4; ++g) {
            const int dvb = 32 * c + 8 * g + 4 * h;
            uint2 st; st.x = pk2(o[c][4*g] * inv, o[c][4*g+1] * inv); st.y = pk2(o[c][4*g+2] * inv, o[c][4*g+3] * inv);
            *(uint2*)(Op + (size_t)qtok * ldo + dvb) = st;
          }
      }
    }
  }
}

DI float max_abs(const float* g, int n) { float m = 0.f; for (int i = 0; i < n; ++i) m = fmaxf(m, fabsf(g[i])); return m; }

DI void phase_attn(const Params& p, int l, char* smem) {
  char* ws = ows(p.ws);
  const u16* proj = (const u16*)(ws + WS_PROJ);
  const u16* dk = (const u16*)(ws + WS_DK); const u16* dv = (const u16*)(ws + WS_DV);
  const u16* mk = (const u16*)(ws + WS_MK); const u16* mv = (const u16*)(ws + WS_MV);
  const u16* gk = (const u16*)(ws + WS_GK); const u16* gv = (const u16*)(ws + WS_GV);
  u16* ob = (u16*)(ws + WS_OB);
  unsigned* ctr = (unsigned*)(ws + WS_CTR) + l;
  int* sitem = (int*)(smem + 65536);
  const float shA = uni(8.f * max_abs(p.in[14] + l * 128, 64) * max_abs(p.in[14] + l * 128 + 64, 64) * LOG2E);
  const float shB = uni(9.797958971132712f * max_abs(p.in[21] + l * 192, 96) * max_abs(p.in[21] + l * 192 + 96, 96) * LOG2E);
  const float shC = uni(8.f * max_abs(p.in[22] + l * 128, 64) * max_abs(p.in[22] + l * 128 + 64, 64) * LOG2E);
  const float lam_init = 0.8f - 0.6f * expf(-0.3f * (float)l);
  float d1 = 0.f, d2 = 0.f;
  { const float* lv = p.in[15] + l * 256; for (int i = 0; i < 64; ++i) { d1 += lv[i] * lv[64 + i]; d2 += lv[128 + i] * lv[192 + i]; } }
  const float lam = uni(expf(d1) - expf(d2) + lam_init);
  const float omul = uni(1.f - lam_init);
  const float* ogain = p.in[16] + l * 128;
  if (otid() == 0) sitem[0] = (int)atomicAdd(ctr, 1u);
  for (int par = 0;; par ^= 1) {
    __syncthreads();
    const int it = sitem[par];
    if (it >= 1280) break;
    if (otid() == 0) sitem[par ^ 1] = (int)atomicAdd(ctr, 1u);
    int cls, idx;
    if (it < 128) { cls = 0; idx = it; } else if (it < 384) { cls = 1; idx = it - 128; } else if (it < 640) { cls = 2; idx = it - 384; }
    else if (it < 768) { cls = 3; idx = it - 640; } else if (it < 1024) { cls = 4; idx = it - 768; } else { cls = 5; idx = it - 1024; }
    const bool lat = cls < 3; const int typ = lat ? cls : cls - 3;
    const int nh = typ == 0 ? 4 : 8;
    const int head = idx % nh; const int sq = idx / nh;
    int q0, kv0, S;
    if (lat) { const int s = sq >> 3, qt = sq & 7; q0 = NCTX + s * DEC_SEQ + qt * 256; kv0 = NCTX + s * SLAT; S = SLAT; }
    else { q0 = sq * 256; kv0 = sq * 256; S = 256; }
    if (typ == 0) {
      attn_item<64, 128, 2>(proj + C_AQ + head * 64, PLD, 256, dk + head * 64, 512, 256, dv + head * 128, 512, q0, kv0, S, shA,
                            ob + head * 128, 1536, lam, omul, ogain, (float*)(ws + WS_O0) + head * 128, smem);
    } else if (typ == 1) {
      attn_item<96, 64, 1>(proj + C_MLAQ + head * 96, PLD, 0, mk + head * 96, 768, 0, mv + head * 64, 512, q0, kv0, S, shB,
                           ob + 512 + head * 64, 1536, 0.f, 1.f, ogain, nullptr, smem);
    } else {
      attn_item<64, 64, 1>(proj + C_CQ + head * 64, PLD, 0, gk + (head >> 2) * 64, 128, 0, gv + (head >> 2) * 64, 128, q0, kv0, S, shC,
                           ob + 1024 + head * 64, 1536, 0.f, 1.f, ogain, nullptr, smem);
    }
  }
}

DI void phase_conv(const Params& p, int l) {
  char* ws = ows(p.ws);
  const u16* u = (const u16*)(ws + WS_PROJ);
  u16* act = (u16*)(ws + WS_ACT);
  const float* cw = p.in[29] + (size_t)l * 3 * UP; const float* cb = p.in[30] + (size_t)l * UP;
  const int gtid = obid() * 512 + otid(), nth = ogrid() * 512;
  constexpr int STRIP = 32, NSTRIP = NTOK / STRIP;
  for (int i = gtid; i < NSTRIP * 352; i += nth) {
    const int strip = i / 352, j = (i % 352) * 8;
    const int t0 = strip * STRIP;
    int pos0, len;
    if (t0 < NCTX) { pos0 = t0 & 255; len = 256; } else { pos0 = (t0 - NCTX) & 2047; len = 2048; }
    float wa0[8], wa1[8], wa2[8], ba[8], wg0[8], wg1[8], wg2[8], bg[8];
    ld8f(cw + j, wa0); ld8f(cw + UP + j, wa1); ld8f(cw + 2 * UP + j, wa2); ld8f(cb + j, ba);
    ld8f(cw + DFF + j, wg0); ld8f(cw + UP + DFF + j, wg1); ld8f(cw + 2 * UP + DFF + j, wg2); ld8f(cb + DFF + j, bg);
    const u16* ua = u + (size_t)t0 * UP + j;
    const uint4 z4 = make_uint4(0, 0, 0, 0);
    uint4 am = pos0 > 0 ? *(const uint4*)(ua - UP) : z4, gm = pos0 > 0 ? *(const uint4*)(ua - UP + DFF) : z4;
    uint4 a0 = *(const uint4*)ua, g0 = *(const uint4*)(ua + DFF);
#pragma unroll 4
    for (int k = 0; k < STRIP; ++k) {
      const bool hn = pos0 + k < len - 1;
      const uint4 ap = hn ? *(const uint4*)(ua + (size_t)(k + 1) * UP) : z4;
      const uint4 gp = hn ? *(const uint4*)(ua + (size_t)(k + 1) * UP + DFF) : z4;
      float xm[8], x0[8], xp[8], ym[8], y0[8], yp[8], o[8];
      unpack8(am, xm); unpack8(a0, x0); unpack8(ap, xp); unpack8(gm, ym); unpack8(g0, y0); unpack8(gp, yp);
#pragma unroll
      for (int q = 0; q < 8; ++q) {
        const float av = xm[q] * wa0[q] + x0[q] * wa1[q] + xp[q] * wa2[q] + ba[q];
        const float gv = ym[q] * wg0[q] + y0[q] * wg1[q] + yp[q] * wg2[q] + bg[q];
        o[q] = av * siluf(gv);
      }
      *(uint4*)(act + (size_t)(t0 + k) * DFF + j) = pack8(o);
      am = a0; a0 = ap; gm = g0; g0 = gp;
    }
  }
}

__global__ void __launch_bounds__(512) mega(Params p) {
  extern __shared__ __attribute__((aligned(16))) char smem[];
  cg::grid_group grid = cg::this_grid();
  char* ws = ows(p.ws);

  __shared__ uint4 xb_words;
  otid_init();
  if (otid() == 0) xb_words = make_uint4(0u, 0u, 0u, 0u);
  __syncthreads();
  XcdBarrier xb = xcd_barrier_post((unsigned*)(ws + WS_BAR), (volatile LAS unsigned*)&xb_words);
  phase0(p, smem);
  grid.sync();
  if (otid() == 0) {
    unsigned* bar = (unsigned*)(ws + WS_BAR);
    const unsigned nxc = gridDim.x >> 5; bool ok = (nxc * 32u == gridDim.x) && nxc <= 16u;
    for (unsigned j = 0; j < 16; ++j) { const unsigned c = xb_ld(&bar[XB_XCNT(j)]); ok = ok && (c == (j < nxc ? 32u : 0u)); }
    { unsigned nloc, nx; xcd_barrier_complete(bar, xb.x, nloc, nx); ((volatile LAS unsigned*)&xb_words)[0] = nloc; ((volatile LAS unsigned*)&xb_words)[1] = nx; }
    const unsigned rank = ((volatile LAS unsigned*)&xb_words)[2];
    ((volatile LAS unsigned*)&xb_words)[3] = blockIdx.x; (void)ok; (void)rank;
  }
  __syncthreads();
  phase0b(p);
#pragma unroll 1
  for (int l = 0; l < DEPTH; ++l) {
    const int vb = __builtin_amdgcn_readfirstlane(((volatile LAS unsigned*)&xb_words)[3]);
    char* ws = ows(p.ws);
    u16* hbuf = (u16*)(ws + WS_H);
    u16* proj = (u16*)(ws + WS_PROJ);
    const float* mod = (const float*)(ws + WS_MOD);
    const float* cosR = (const float*)(ws + WS_ROPE) + 131072; const float* sinR = cosR + 32768;
    convert_layer(p, l, smem);
    xcd_barrier(xb);
    const float* modl = mod + (size_t)l * 5 * 6144;
    const float* xs0 = l == 0 ? p.in[0] : p.out; const float* xs1 = l == 0 ? p.in[1] : p.out + (size_t)NCTX * 1024;
    norm_mod(p, p.in[12] + l * 1024, modl, 0, 1024, xs0, xs1);
    xcd_barrier(xb);
    phase3_cached(p, l);
    { const float* cosH = (const float*)(ws + WS_ROPE);
      EpiProj2 e{proj, (u16*)(ws + WS_DK), (u16*)(ws + WS_DV), (u16*)(ws + WS_GK), (u16*)(ws + WS_GV), (u16*)(ws + WS_CKVN), (float*)(ws + WS_KPE),
                 (float*)(ws + WS_QDSS), p.out, p.in[14] + l * 128, p.in[17] + l * 256, p.in[19] + l * 128, p.in[22] + l * 128, cosH, cosH + 65536, l};
      gemm_phase(hbuf, 1024, (const u16*)(ws + WS_WIN), 1024, 1024, 64, 23, smem, e, 0, 64 * 23 + 16, vb);
      EpiKvup ekc{(u16*)(ws + WS_MK), (u16*)(ws + WS_MV), (const float*)(ws + WS_KPE), p.in[21] + l * 192 + 96, cosR, sinR};
      PreCkv pc{p.in[5], p.in[6], p.in[19] + l * 128, (u16*)(ws + WS_CKVN), (float*)(ws + WS_KPE), l};
      gemm_phase<EpiKvup, PreCkv, 2>((const u16*)(ws + WS_CKVN), 256, (const u16*)(ws + WS_WKV), 256, 256, 4, 4, smem, ekc, 64 * 23, 64 * 23 + 16, vb, pc); }
    xcd_barrier(xb);
    {
      EpiQup eq{proj, p.in[21] + l * 192, cosR, sinR, (const float*)(ws + WS_QDSS)};
      gemm_phase(proj + C_BQD, PLD, (const u16*)(ws + WS_WQU), 256, 256, 64, 4, smem, eq, 0, 512, vb);
      EpiKvup ek{(u16*)(ws + WS_MK), (u16*)(ws + WS_MV), (const float*)(ws + WS_KPE), p.in[21] + l * 192 + 96, cosR, sinR};
      gemm_phase<EpiKvup, NoPre, 1>((const u16*)(ws + WS_CKVN), 256, (const u16*)(ws + WS_WKV), 256, 256, 64, 4, smem, ek, 256, 512, vb);
    }
    xcd_barrier(xb);
    phase_attn(p, l, smem);
    xcd_barrier(xb);
    merge_phase((const u16*)(ws + WS_OB), (const u16*)(ws + WS_WB), proj, hbuf, smem, vb);
    xcd_barrier(xb);
    { EpiResid er{p.out, modl, 2048, xs0, xs1}; gemm_phase(hbuf, 1024, (const u16*)(ws + WS_WO), 1024, 1024, 64, 4, smem, er, 0, 256, vb); }
    xcd_barrier(xb);
    norm_mod(p, p.in[27] + l * 1024, modl, 3072, 4096, p.out, p.out + (size_t)NCTX * 1024);
    xcd_barrier(xb);
    { EpiConv ec{(u16*)(ws + WS_ACT), (u16*)(ws + WS_HALO), p.in[29] + (size_t)l * 3 * UP, p.in[30] + (size_t)l * UP};
      gemm_phase(hbuf, 1024, (const u16*)(ws + WS_WUP), 1024, 1024, 64, 22, smem, ec, 0, 64 * 22, vb); }
    xcd_barrier(xb);
    { EpiResid er{p.out, modl, 5120, p.out, p.out + (size_t)NCTX * 1024}; PreFix pf{(u16*)(ws + WS_ACT), (const u16*)(ws + WS_HALO), p.in[29] + (size_t)l * 3 * UP, p.in[30] + (size_t)l * UP};
      gemm_phase((const u16*)(ws + WS_ACT), DFF, (const u16*)(ws + WS_WD), DFF, DFF, 64, 4, smem, er, 0, 256, vb, pf); }
    xcd_barrier(xb);
  }
}

extern "C" void kernel_launch(void* const* d_in, const int* in_sizes, int n_in, void* d_out, int out_size, void* d_ws, size_t ws_size, hipStream_t stream) {
  static int grid_blocks = 0;
  if (grid_blocks == 0) {
    if (n_in != 32 || ws_size < WS_END) { fprintf(stderr, "kernel_launch: bad n_in %d or ws_size %zu < %zu\n", n_in, ws_size, (size_t)WS_END); grid_blocks = -1; return; }
    int dev = 0, cus = 0, per_cu = 0;
    hipGetDevice(&dev);
    hipDeviceGetAttribute(&cus, hipDeviceAttributeMultiprocessorCount, dev);
    hipFuncSetAttribute((const void*)mega, hipFuncAttributeMaxDynamicSharedMemorySize, LDS_BYTES);
    hipOccupancyMaxActiveBlocksPerMultiprocessor(&per_cu, (const void*)mega, 512, LDS_BYTES);
    if (per_cu < 1) per_cu = 1;
    grid_blocks = cus * per_cu;
  }
  if (grid_blocks < 0) return;
  (void)hipMemsetAsync((char*)d_ws + WS_CTR, 0, 256 + XCD_BAR_WORDS_C * 4, stream);
  Params p{};
  for (int i = 0; i < 32; ++i) p.in[i] = (const float*)d_in[i];
  p.out = (float*)d_out; p.ws = (char*)d_ws;
  void* args[] = {&p};
  hipError_t e = hipLaunchCooperativeKernel((const void*)mega, dim3(grid_blocks), dim3(512), args, LDS_BYTES, stream);
  if (e != hipSuccess) fprintf(stderr, "cooperative launch failed: %s (grid %d)\n", hipGetErrorString(e), grid_blocks);
}
```
